# Optimizing an MI355X kernel written in HIP

```python
import math
import jax
import jax.numpy as jnp
from jax import lax
import numpy as np

D_MODEL = 1024
BATCH = 8
SEQ = 4096
DEPTH = 1

GRID_W = 64
CTX_LEN = 256
MIX_W = D_MODEL
NA_W = MIX_W // 2
NA_DH = 64
NA_HEADS = NA_W // NA_DH
NA_KR = 8
NA_KC = 16
S5_W = MIX_W - NA_W
S5_CG = 16
S5_G = S5_W // S5_CG
S5_P = 64
D_FF = ((8 * D_MODEL // 3 + 255) // 256) * 256
IN_COLS = 3 * NA_W + S5_W
DN_ALPHA = (2.0 * DEPTH) ** 0.25
DN_BETA = (8.0 * DEPTH) ** -0.25
LN_EPS = 1e-6
DT_MIN = 1e-3
DT_MAX = 1e-1

kernel_name = 'hybrid_na_s5_macaron_dit_layer'


def layer_norm(x, g, b):
    xf = x.astype(jnp.float32)
    mu = jnp.mean(xf, axis=-1, keepdims=True)
    var = jnp.mean(jnp.square(xf - mu), axis=-1, keepdims=True)
    return ((xf - mu) * lax.rsqrt(var + LN_EPS)).astype(x.dtype) * g + b


def post_norm(stream, update, g, b):
    return layer_norm(DN_ALPHA * stream + update, g, b)


def modulate(h, shift, scale):
    return h * (1 + scale) + shift


def swiglu(h, w_up, w_down):
    a, g = jnp.split(h @ w_up, 2, axis=-1)
    return (jax.nn.silu(g) * a) @ w_down


def neighborhood_attention(q, k, v, k_ctx, v_ctx, rpb):
    B, S, H, Dh = q.shape
    rows = S // GRID_W
    kr = min(NA_KR, rows)
    kc = NA_KC
    n_win = kr * kc
    scale = Dh ** -0.5
    qg = q.reshape(B, rows, GRID_W, H, Dh)
    kg = k.reshape(B, rows, GRID_W, H, Dh)
    vg = v.reshape(B, rows, GRID_W, H, Dh)
    cols = jnp.arange(GRID_W)
    col_start = jnp.clip(cols - kc // 2, 0, GRID_W - kc)
    col_idx = col_start[:, None] + jnp.arange(kc)[None, :]
    col_off = col_idx - cols[:, None] + (NA_KC - 1)
    rpb_c = rpb[:, :, col_off]

    def row_block(r):
        r0 = jnp.clip(r - NA_KR // 2, 0, rows - kr)
        qr = lax.dynamic_index_in_dim(qg, r, axis=1, keepdims=False)
        kb = lax.dynamic_slice_in_dim(kg, r0, kr, axis=1)[:, :, col_idx]
        vb = lax.dynamic_slice_in_dim(vg, r0, kr, axis=1)[:, :, col_idx]
        row_off = r0 + jnp.arange(kr) - r + (NA_KR - 1)
        bias = jnp.transpose(rpb_c[:, row_off], (0, 2, 1, 3))
        s_win = jnp.einsum('bwhd,biwjhd->bhwij', qr, kb) * scale + bias
        s_ctx = jnp.einsum('bwhd,bchd->bhwc', qr, k_ctx) * scale
        s = jnp.concatenate([s_win.reshape(B, H, GRID_W, n_win), s_ctx], axis=-1)
        p = jax.nn.softmax(s.astype(jnp.float32), axis=-1).astype(q.dtype)
        p_win = p[..., :n_win].reshape(B, H, GRID_W, kr, kc)
        return (jnp.einsum('bhwij,biwjhd->bwhd', p_win, vb)
                + jnp.einsum('bhwc,bchd->bwhd', p[..., n_win:], v_ctx))

    o = lax.map(row_block, jnp.arange(rows))
    return jnp.moveaxis(o, 0, 1).reshape(B, S, H * Dh)


def context_attention(q, k, v):
    B, L, H, Dh = q.shape
    s = jnp.einsum('bqhd,bkhd->bhqk', q, k) * (Dh ** -0.5)
    p = jax.nn.softmax(s.astype(jnp.float32), axis=-1).astype(q.dtype)
    return jnp.einsum('bhqk,bkhd->bqhd', p, v).reshape(B, L, H * Dh)


def s5_discretise(a_re, a_im, log_dt, b_re, b_im):
    lam = lax.complex(a_re.astype(jnp.float32), a_im.astype(jnp.float32))
    dt = jnp.exp(log_dt.astype(jnp.float32))[:, None]
    a_bar = jnp.exp(lam * dt)
    b = lax.complex(b_re.astype(jnp.float32), b_im.astype(jnp.float32))
    b_bar = ((a_bar - 1.0) / lam)[..., None] * b
    return a_bar, b_bar


def _linear_combine(left, right):
    a_l, b_l = left
    a_r, b_r = right
    return a_r * a_l, a_r * b_l + b_r


def s5_scan(u, a_bar, b_bar, h0, reverse):
    bu = jnp.einsum('gpc,blgc->blgp', b_bar, u.astype(jnp.complex64))
    if h0 is not None:
        edge = -1 if reverse else 0
        bu = bu.at[:, edge].add(a_bar * h0)
    a_seq = jnp.broadcast_to(a_bar, (1, u.shape[1]) + a_bar.shape)
    _, h = lax.associative_scan(_linear_combine, (a_seq, bu), axis=1, reverse=reverse)
    return h


def s5_readout(c_mat, h):
    return jnp.einsum('gcp,blgp->blgc', c_mat, h).real


def s5_glu(y, w_glu, b_glu):
    g = jax.nn.gelu(y)
    return g * jax.nn.sigmoid(g @ w_glu + b_glu)


def s5_mixer(u, u_c, a_re, a_im, log_dt, b_re, b_im, c_re, c_im, d, w_glu, b_glu, with_ctx_out):
    B, S, _ = u.shape
    L = u_c.shape[1]
    ug = u.reshape(B, S, S5_G, S5_CG)
    ucg = u_c.reshape(B, L, S5_G, S5_CG)
    y = d * ug
    y_c = d * ucg if with_ctx_out else None
    for direction in range(2):
        rev = direction == 1
        a_bar, b_bar = s5_discretise(a_re[direction], a_im[direction], log_dt[direction],
                                     b_re[direction], b_im[direction])
        c_mat = lax.complex(c_re[direction].astype(jnp.float32), c_im[direction].astype(jnp.float32))
        h_ctx = s5_scan(ucg, a_bar, b_bar, None, rev)
        h0 = h_ctx[:, 0] if rev else h_ctx[:, -1]
        h_lat = s5_scan(ug, a_bar, b_bar, h0, rev)
        y = y + s5_readout(c_mat, h_lat).astype(y.dtype)
        if with_ctx_out:
            y_c = y_c + s5_readout(c_mat, h_ctx).astype(y_c.dtype)
    y = s5_glu(y.reshape(B, S, S5_W), w_glu, b_glu)
    y_c = s5_glu(y_c.reshape(B, L, S5_W), w_glu, b_glu) if with_ctx_out else None
    return y, y_c


def parallel_mixer(h, h_c, w_in, rpb, a_re, a_im, log_dt, b_re, b_im, c_re, c_im, d,
                   w_glu, b_glu, w_out, with_ctx_out):
    B, S, _ = h.shape
    L = h_c.shape[1]
    splits = [NA_W, 2 * NA_W, 3 * NA_W]
    q, k, v, u = jnp.split(h @ w_in, splits, axis=-1)
    q_c, k_c, v_c, u_c = jnp.split(h_c @ w_in, splits, axis=-1)

    def heads(t):
        return t.reshape(t.shape[0], t.shape[1], NA_HEADS, NA_DH)

    y_na = neighborhood_attention(heads(q), heads(k), heads(v), heads(k_c), heads(v_c), rpb)
    y_s5, y_s5_c = s5_mixer(u, u_c, a_re, a_im, log_dt, b_re, b_im, c_re, c_im, d,
                            w_glu, b_glu, with_ctx_out)
    y = jnp.concatenate([y_na, y_s5], axis=-1) @ w_out
    if with_ctx_out:
        y_na_c = context_attention(heads(q_c), heads(k_c), heads(v_c))
        y_c = jnp.concatenate([y_na_c, y_s5_c], axis=-1) @ w_out
    else:
        y_c = None
    return y, y_c


def setup_inputs(seed: int = 0) -> dict:
    key = jax.random.key(seed)
    ks = jax.random.split(key, 26)
    f32 = jnp.float32

    def nrm(k, shape, s):
        return jax.random.normal(k, shape, f32) * s

    D = D_MODEL
    return {
        'x': nrm(ks[0], (BATCH, SEQ, D), 1.0),
        'c': nrm(ks[1], (BATCH, D), 1.0),
        'ctx': nrm(ks[2], (BATCH, CTX_LEN, D), 1.0),
        'c_ctx': nrm(ks[3], (D,), 1.0),
        'w_ada': nrm(ks[4], (DEPTH, D, 9 * D), 0.5 * D ** -0.5),
        'b_ada': nrm(ks[5], (DEPTH, 9 * D), 0.02),
        'ln_g': 1.0 + nrm(ks[6], (DEPTH, 3, D), 0.02),
        'ln_b': nrm(ks[7], (DEPTH, 3, D), 0.02),
        'ffn1_w_up': nrm(ks[8], (DEPTH, D, 2 * D_FF), D ** -0.5),
        'ffn1_w_down': nrm(ks[9], (DEPTH, D_FF, D), DN_BETA * D_FF ** -0.5),
        'w_in': nrm(ks[10], (DEPTH, D, IN_COLS), D ** -0.5),
        'na_rpb': nrm(ks[11], (DEPTH, NA_HEADS, 2 * NA_KR - 1, 2 * NA_KC - 1), 0.02),
        's5_a_re': -0.5 + nrm(ks[12], (DEPTH, 2, S5_G, S5_P), 0.01),
        's5_a_im': math.pi * jnp.arange(S5_P, dtype=f32) + nrm(ks[13], (DEPTH, 2, S5_G, S5_P), 0.01),
        's5_log_dt': jax.random.uniform(ks[14], (DEPTH, 2, S5_G), f32, math.log(DT_MIN), math.log(DT_MAX)),
        's5_b_re': nrm(ks[15], (DEPTH, 2, S5_G, S5_P, S5_CG), (2 * S5_CG) ** -0.5),
        's5_b_im': nrm(ks[16], (DEPTH, 2, S5_G, S5_P, S5_CG), (2 * S5_CG) ** -0.5),
        's5_c_re': nrm(ks[17], (DEPTH, 2, S5_G, S5_CG, S5_P), (2 * S5_P) ** -0.5),
        's5_c_im': nrm(ks[18], (DEPTH, 2, S5_G, S5_CG, S5_P), (2 * S5_P) ** -0.5),
        's5_d': nrm(ks[19], (DEPTH, S5_G, S5_CG), 1.0),
        's5_w_glu': nrm(ks[20], (DEPTH, S5_W, S5_W), S5_W ** -0.5),
        's5_b_glu': nrm(ks[21], (DEPTH, S5_W), 0.02),
        'w_out': nrm(ks[22], (DEPTH, MIX_W, D), DN_BETA * MIX_W ** -0.5),
        'ffn2_w_up': nrm(ks[23], (DEPTH, D, 2 * D_FF), D ** -0.5),
        'ffn2_w_down': nrm(ks[24], (DEPTH, D_FF, D), DN_BETA * D_FF ** -0.5),
    }


def reference(x, c, ctx, c_ctx, w_ada, b_ada, ln_g, ln_b, ffn1_w_up, ffn1_w_down, w_in, na_rpb,
              s5_a_re, s5_a_im, s5_log_dt, s5_b_re, s5_b_im, s5_c_re, s5_c_im, s5_d,
              s5_w_glu, s5_b_glu, w_out, ffn2_w_up, ffn2_w_down):
    h_c = ctx
    for layer in range(DEPTH):
        last = layer == DEPTH - 1
        mod = jnp.split((jax.nn.silu(c) @ w_ada[layer] + b_ada[layer])[:, None, :], 9, axis=-1)
        mod_c = jnp.split(jax.nn.silu(c_ctx) @ w_ada[layer] + b_ada[layer], 9, axis=-1)

        x = post_norm(x, 0.5 * mod[2] * swiglu(modulate(x, mod[0], mod[1]), ffn1_w_up[layer], ffn1_w_down[layer]),
                      ln_g[layer, 0], ln_b[layer, 0])
        h_c = post_norm(h_c, 0.5 * mod_c[2] * swiglu(modulate(h_c, mod_c[0], mod_c[1]),
                                                     ffn1_w_up[layer], ffn1_w_down[layer]),
                        ln_g[layer, 0], ln_b[layer, 0])

        y, y_c = parallel_mixer(modulate(x, mod[3], mod[4]), modulate(h_c, mod_c[3], mod_c[4]),
                                w_in[layer], na_rpb[layer], s5_a_re[layer], s5_a_im[layer], s5_log_dt[layer],
                                s5_b_re[layer], s5_b_im[layer], s5_c_re[layer], s5_c_im[layer], s5_d[layer],
                                s5_w_glu[layer], s5_b_glu[layer], w_out[layer], not last)
        x = post_norm(x, mod[5] * y, ln_g[layer, 1], ln_b[layer, 1])

        x = post_norm(x, 0.5 * mod[8] * swiglu(modulate(x, mod[6], mod[7]), ffn2_w_up[layer], ffn2_w_down[layer]),
                      ln_g[layer, 2], ln_b[layer, 2])
        if not last:
            h_c = post_norm(h_c, mod_c[5] * y_c, ln_g[layer, 1], ln_b[layer, 1])
            h_c = post_norm(h_c, 0.5 * mod_c[8] * swiglu(modulate(h_c, mod_c[6], mod_c[7]),
                                                         ffn2_w_up[layer], ffn2_w_down[layer]),
                            ln_g[layer, 2], ln_b[layer, 2])
    return x
```

```cpp
#include <hip/hip_runtime.h>
#include <hip/hip_cooperative_groups.h>
#include <cstdio>
namespace cg = cooperative_groups;

#define LAS __attribute__((address_space(3)))
#define DEVI __device__ __forceinline__
typedef unsigned short bf16_t;
typedef short bf16x8 __attribute__((ext_vector_type(8)));
typedef short s16x4 __attribute__((ext_vector_type(4)));
typedef float f32x4 __attribute__((ext_vector_type(4)));
typedef float f32x2 __attribute__((ext_vector_type(2)));
typedef unsigned u32x4 __attribute__((ext_vector_type(4)));
typedef unsigned u32x2 __attribute__((ext_vector_type(2)));

#ifndef PH_MASK
#define PH_MASK 0x7fff
#endif
#define PH_ON(k) (((PH_MASK) >> (k)) & 1)
#ifndef N_LAUNCH_MODE
#define N_LAUNCH_MODE 1
#endif

constexpr int D = 1024, SEQ = 4096, NB = 8, CTXL = 256, DFF = 2816;
constexpr int MLAT = NB * SEQ, MCTX = NB * CTXL, MALL = MLAT + MCTX;
constexpr int UR_ROWS = 1280, UR_LD = 768;
constexpr int NPHASE = 15;
constexpr float ALPHA = 1.189207115002721f;
constexpr float LOG2E = 1.4426950408889634f;
constexpr int LDS_BYTES = 131072;

struct Params {
    const float *x, *c, *ctx, *c_ctx, *w_ada, *b_ada, *ln_g, *ln_b, *w_up1, *w_dn1, *w_in, *rpb;
    const float *a_re, *a_im, *log_dt, *b_re, *b_im, *c_re, *c_im, *s5d, *w_glu, *b_glu, *w_out, *w_up2, *w_dn2;
    float* out;
    float* mod;
    bf16_t *wup1t, *wdn1t, *wint, *wglut, *woutt, *wup2t, *wdn2t;
    float* kt;
    bf16_t* wE;
    bf16_t* wY;
    bf16_t* A;
    float* V;
    bf16_t* hid;
    bf16_t* qkv;
    bf16_t* Ur;
    float* E;
    int ph_lo, ph_hi;
};

DEVI unsigned cvt_pk_bf16(float lo, float hi) { unsigned r; asm volatile("v_cvt_pk_bf16_f32 %0, %1, %2" : "=v"(r) : "v"(lo), "v"(hi)); return r; }
DEVI float bf2f(unsigned short b) { return __uint_as_float(((unsigned)b) << 16); }
DEVI float fast_sigmoid(float v) { return __builtin_amdgcn_rcpf(1.0f + __builtin_amdgcn_exp2f(-v * LOG2E)); }
DEVI float gelu_tanh(float v) { const float z = 0.7978845608028654f * (v + 0.044715f * v * v * v); return v * fast_sigmoid(2.0f * z); }

namespace pg8 {
constexpr int BM = 256, BK = 64, HALF = 128, HTB = HALF * BK * 2, STAGE_BYTES = 8 * HTB, NXCD = 8, WGM = 8;
DEVI int lds_byte(int r, int c) { const int st = (r >> 4) * 2 + (c >> 5), rr = r & 15, cc = c & 31, ob = rr * 64 + cc * 2; return st * 1024 + (ob ^ (((ob >> 9) & 1) << 5)); }
DEVI void stage_rc(int b, int& R, int& C) { const int st = b / 1024, sb = b % 1024, swz = sb ^ (((sb >> 9) & 1) << 5); R = (st >> 1) * 16 + swz / 64; C = (st & 1) * 32 + (swz % 64) / 2; }
DEVI int perm32(int rho) { const int n = rho >> 4, i = rho & 15; return 8 * (i >> 2) + 4 * n + (i & 3); }
struct Unit { int pm, pn; };
struct Gemm { const bf16_t* A; const bf16_t* Bt; int lda, ldb, K; };

struct StaticOrder {
    int nM, nN, nwg, G, c;
    DEVI void init(int M, int N, int G_, int c_) { nM = M / BM; nN = N / BM; nwg = nM * nN; G = G_; c = c_; }
    DEVI bool next(int i, Unit& u) const {
        const long L = (long)i * G + c; if (L >= nwg) return false;
        int wgid = (int)L; { const int q = nwg / NXCD, r = nwg % NXCD, xcd = wgid % NXCD, off = wgid / NXCD; wgid = (xcd < r ? xcd * (q + 1) : r * (q + 1) + (xcd - r) * q) + off; }
        const int nig = WGM * nN, gid = wgid / nig, fm = gid * WGM, gsz = (nM - fm) < WGM ? (nM - fm) : WGM;
        u.pm = fm + ((wgid % nig) % gsz); u.pn = (wgid % nig) / gsz; return true;
    }
    DEVI void a_ready(const Unit&) const {}
    DEVI void done(const Unit&) const {}
};
struct GroupOrder {
    int ng, mt, nt, mstride, nstride, G, c;
    DEVI bool next(int i, Unit& u) const {
        const long L = (long)i * G + c; if (L >= (long)ng * mt * nt) return false;
        const int per = mt * nt, g = (int)L / per, rem = (int)L % per;
        u.pm = g * mstride + rem % mt; u.pn = g * nstride + rem / mt; return true;
    }
    DEVI void a_ready(const Unit&) const {}
    DEVI void done(const Unit&) const {}
};

template <class Epi, class Sched>
DEVI void gemm_phase(LAS unsigned char* lds, const Gemm g, const Sched& S, const Epi& E) {
    const int tid = threadIdx.x, wid = __builtin_amdgcn_readfirstlane(tid >> 6), lane = tid & 63, wr = wid >> 2, wc = wid & 3, fr = lane & 15, fq = lane >> 4;
    const int K = g.K, nt = K / BK;
    unsigned voffA[2], voffB[2];
#pragma unroll
    for (int i = 0; i < 2; ++i) { int R, C; stage_rc(tid * 16 + i * 8192, R, C); const int Rb = Epi::PERM ? ((R & ~31) + perm32(R & 31)) : R;
        voffA[i] = (unsigned)(R * g.lda + C) * 2u; voffB[i] = (unsigned)(Rb * g.ldb + C) * 2u; }
    const size_t kstep = (size_t)(BK * 2);
    const size_t hstepA = (size_t)HALF * g.lda * 2, hstepB = (size_t)HALF * g.ldb * 2;
    const size_t tstepA = 2 * hstepA, tstepB = 2 * hstepB;
    const unsigned ldsw = (unsigned)wid * 1024u;
    const int aoff = lds_byte(wr * 64 + fr, fq * 8), boff = lds_byte(wc * 32 + fr, fq * 8);
#define PG8_SA(b, h) (((b) * 2 + (h)) * HTB)
#define PG8_SB(b, h) ((4 + (b) * 2 + (h)) * HTB)
#define PG8_STAGE(bufoff, gbase, voff) do { _Pragma("unroll") for (int _i = 0; _i < 2; ++_i) \
        __builtin_amdgcn_global_load_lds((const unsigned*)((const char*)(gbase) + (voff)[_i]), (LAS unsigned*)(lds + (bufoff) + ldsw + _i * 8192), 16, 0, 0); } while (0)
#define PG8_LDA(dst, b, h) do { _Pragma("unroll") for (int m = 0; m < 4; ++m) _Pragma("unroll") for (int k = 0; k < 2; ++k) dst[m][k] = *(const LAS bf16x8*)(lds + PG8_SA(b, h) + aoff + m * 2048 + k * 1024); } while (0)
#define PG8_LDB(dst, b, h) do { _Pragma("unroll") for (int n = 0; n < 2; ++n) _Pragma("unroll") for (int k = 0; k < 2; ++k) dst[n][k] = *(const LAS bf16x8*)(lds + PG8_SB(b, h) + boff + n * 2048 + k * 1024); } while (0)
#define PG8_MMA(ai, bj, At, Bt) do { __builtin_amdgcn_s_setprio(1); _Pragma("unroll") for (int m = 0; m < 4; ++m) _Pragma("unroll") for (int n = 0; n < 2; ++n) _Pragma("unroll") for (int k = 0; k < 2; ++k) \
        acc[ai][bj][m][n] = __builtin_amdgcn_mfma_f32_16x16x32_bf16(Bt[n][k], At[m][k], acc[ai][bj][m][n], 0, 0, 0); __builtin_amdgcn_s_setprio(0); } while (0)
#define PG8_WAIT_V(n) asm volatile("s_waitcnt vmcnt(" #n ")" ::: "memory")
#define PG8_WAIT_L(n) asm volatile("s_waitcnt lgkmcnt(" #n ")" ::: "memory")
#define PG8_BAR __builtin_amdgcn_s_barrier()
#define PG8_SCHED __builtin_amdgcn_sched_barrier(0)
    Unit cur, nxt; int ui = 0;
    if (!S.next(0, cur)) return;
    f32x4 acc[2][2][4][2];
#pragma unroll
    for (int a = 0; a < 2; ++a)
#pragma unroll
        for (int b = 0; b < 2; ++b)
#pragma unroll
            for (int m = 0; m < 4; ++m)
#pragma unroll
                for (int n = 0; n < 2; ++n) acc[a][b][m][n] = (f32x4){0.f, 0.f, 0.f, 0.f};
    bf16x8 At[4][2], B0[2][2], B1[2][2];
    const char* cA = (const char*)g.A + (size_t)cur.pm * tstepA; const char* cB = (const char*)g.Bt + (size_t)cur.pn * tstepB;
    S.a_ready(cur);
    PG8_STAGE(PG8_SB(0, 0), cB, voffB); PG8_STAGE(PG8_SA(0, 0), cA, voffA); PG8_STAGE(PG8_SB(0, 1), cB + hstepB, voffB); PG8_STAGE(PG8_SA(0, 1), cA + hstepA, voffA);
    if (wr == 1) PG8_BAR;
    PG8_WAIT_V(4); PG8_BAR;
    PG8_STAGE(PG8_SB(1, 0), cB + kstep, voffB); PG8_STAGE(PG8_SA(1, 0), cA + kstep, voffA); PG8_STAGE(PG8_SB(1, 1), cB + hstepB + kstep, voffB);
    PG8_WAIT_V(6); PG8_BAR;
    for (;;) {
        const bool has_next = S.next(ui + 1, nxt);
        const char* nA = has_next ? (const char*)g.A + (size_t)nxt.pm * tstepA : cA; const char* nB = has_next ? (const char*)g.Bt + (size_t)nxt.pn * tstepB : cB;
        for (int t = 0; t < nt; t += 2) {
            const bool last = (t == nt - 2);
            const char* a1 = cA + (size_t)(t + 1) * kstep;
            const char* a2 = last ? nA : cA + (size_t)(t + 2) * kstep; const char* b2 = last ? nB : cB + (size_t)(t + 2) * kstep;
            const char* a3 = a2 + kstep; const char* b3 = b2 + kstep;
            if (last && has_next) S.a_ready(nxt);
            PG8_LDB(B0, 0, 0); PG8_SCHED; PG8_LDA(At, 0, 0); PG8_STAGE(PG8_SA(1, 1), a1 + hstepA, voffA);
            PG8_WAIT_L(8); PG8_BAR; PG8_WAIT_L(0); PG8_MMA(0, 0, At, B0); PG8_BAR; PG8_SCHED;
            PG8_LDB(B1, 0, 1); PG8_STAGE(PG8_SB(0, 0), b2, voffB);
            PG8_BAR; PG8_WAIT_L(0); PG8_MMA(0, 1, At, B1); PG8_BAR;
            PG8_LDA(At, 0, 1); PG8_STAGE(PG8_SA(0, 0), a2, voffA);
            PG8_BAR; PG8_WAIT_L(0); PG8_MMA(1, 0, At, B0); PG8_BAR; PG8_SCHED;
            PG8_STAGE(PG8_SB(0, 1), b2 + hstepB, voffB);
            PG8_WAIT_V(6); PG8_BAR; PG8_MMA(1, 1, At, B1); PG8_BAR;
            PG8_LDB(B0, 1, 0); PG8_SCHED; PG8_LDA(At, 1, 0); PG8_STAGE(PG8_SA(0, 1), a2 + hstepA, voffA);
            PG8_WAIT_L(8); PG8_BAR; PG8_WAIT_L(0); PG8_MMA(0, 0, At, B0); PG8_BAR; PG8_SCHED;
            PG8_LDB(B1, 1, 1); PG8_STAGE(PG8_SB(1, 0), b3, voffB);
            PG8_BAR; PG8_WAIT_L(0); PG8_MMA(0, 1, At, B1); PG8_BAR;
            PG8_LDA(At, 1, 1); PG8_STAGE(PG8_SA(1, 0), a3, voffA);
            PG8_BAR; PG8_WAIT_L(0); PG8_MMA(1, 0, At, B0); PG8_BAR; PG8_SCHED;
            PG8_STAGE(PG8_SB(1, 1), b3 + hstepB, voffB);
            PG8_WAIT_V(6); PG8_BAR; PG8_MMA(1, 1, At, B1); PG8_BAR;
        }
        E(acc, cur, wr, wc, fr, fq); S.done(cur);
        if (!has_next) break;
#pragma unroll
        for (int a = 0; a < 2; ++a)
#pragma unroll
            for (int b = 0; b < 2; ++b)
#pragma unroll
                for (int m = 0; m < 4; ++m)
#pragma unroll
                    for (int n = 0; n < 2; ++n) acc[a][b][m][n] = (f32x4){0.f, 0.f, 0.f, 0.f};
        cur = nxt; cA = nA; cB = nB; ++ui;
    }
    PG8_WAIT_V(0);
    if (wr == 0) PG8_BAR;
    PG8_BAR;
#undef PG8_SA
#undef PG8_SB
#undef PG8_STAGE
#undef PG8_LDA
#undef PG8_LDB
#undef PG8_MMA
#undef PG8_WAIT_V
#undef PG8_WAIT_L
#undef PG8_BAR
#undef PG8_SCHED
}
}

typedef f32x4 AccT[2][2][4][2];

struct EpiSwiglu {
    static constexpr bool PERM = true;
    bf16_t* O;
    DEVI void operator()(const AccT& acc, const pg8::Unit& u, int wr, int wc, int fr, int fq) const {
        const int row0 = u.pm * 256 + wr * 64 + fr, col0 = u.pn * 128 + wc * 32 + 8 * fq;
#pragma unroll
        for (int ai = 0; ai < 2; ++ai)
#pragma unroll
            for (int m = 0; m < 4; ++m) {
                bf16_t* rowp = O + (size_t)(row0 + ai * 128 + m * 16) * DFF + col0;
                float h[8];
#pragma unroll
                for (int n = 0; n < 2; ++n)
#pragma unroll
                    for (int e = 0; e < 4; ++e) { const float a = acc[ai][0][m][n][e], gg = acc[ai][1][m][n][e]; h[n * 4 + e] = a * gg * fast_sigmoid(gg); }
                u32x4 w; w.x = cvt_pk_bf16(h[0], h[1]); w.y = cvt_pk_bf16(h[2], h[3]); w.z = cvt_pk_bf16(h[4], h[5]); w.w = cvt_pk_bf16(h[6], h[7]);
                *(u32x4*)rowp = w;
            }
    }
};
struct EpiResGate {
    static constexpr bool PERM = false;
    const float* resLat; const float* resCtx; float* out; const float* mod; int seg; float gs;
    DEVI void operator()(const AccT& acc, const pg8::Unit& u, int wr, int wc, int fr, int fq) const {
        const int row0 = u.pm * 256 + wr * 64 + fr, col0 = u.pn * 256 + wc * 32 + 4 * fq;
        const bool isctx = u.pm >= (MLAT / 256); const int b = isctx ? 8 : (u.pm >> 4);
        const float* gp = mod + (size_t)b * 9216 + seg * 1024 + col0;
        f32x4 gv[2][2];
#pragma unroll
        for (int bj = 0; bj < 2; ++bj)
#pragma unroll
            for (int n = 0; n < 2; ++n) gv[bj][n] = *(const f32x4*)(gp + bj * 128 + n * 16) * gs;
#pragma unroll
        for (int ai = 0; ai < 2; ++ai)
#pragma unroll
            for (int m = 0; m < 4; ++m) {
                const int r = row0 + ai * 128 + m * 16;
                const float* rp = isctx ? resCtx + (size_t)(r - MLAT) * D + col0 : resLat + (size_t)r * D + col0;
                float* op = out + (size_t)r * D + col0;
#pragma unroll
                for (int bj = 0; bj < 2; ++bj)
#pragma unroll
                    for (int n = 0; n < 2; ++n) { const f32x4 rv = *(const f32x4*)(rp + bj * 128 + n * 16); *(f32x4*)(op + bj * 128 + n * 16) = rv * ALPHA + gv[bj][n] * acc[ai][bj][m][n]; }
            }
    }
};
struct EpiQKVU {
    static constexpr bool PERM = true;
    bf16_t* qkv; bf16_t* Ur;
    DEVI void operator()(const AccT& acc, const pg8::Unit& u, int wr, int wc, int fr, int fq) const {
        const int row0 = u.pm * 256 + wr * 64 + fr;
#pragma unroll
        for (int ai = 0; ai < 2; ++ai)
#pragma unroll
            for (int m = 0; m < 4; ++m) {
                const int r = row0 + ai * 128 + m * 16;
#pragma unroll
                for (int bj = 0; bj < 2; ++bj) {
                    const f32x4 v0 = acc[ai][bj][m][0], v1 = acc[ai][bj][m][1];
                    u32x4 w; w.x = cvt_pk_bf16(v0[0], v0[1]); w.y = cvt_pk_bf16(v0[2], v0[3]); w.z = cvt_pk_bf16(v1[0], v1[1]); w.w = cvt_pk_bf16(v1[2], v1[3]);
                    if (u.pn < 6) { *(u32x4*)(qkv + (size_t)r * 1536 + u.pn * 256 + bj * 128 + wc * 32 + 8 * fq) = w; }
                    else {
                        const int ucol = (u.pn - 6) * 256 + bj * 128 + wc * 32 + 8 * fq, g = ucol >> 4, cp = ucol & 15;
                        int R, s;
                        if (r < MLAT) { const int b = r >> 12, t = r & 4095; R = b * 128 + (t >> 5); s = t & 31; }
                        else { const int rc = r - MLAT, b = rc >> 8, t = rc & 255; R = 1024 + b * 8 + (t >> 5); s = t & 31; }
                        *(u32x4*)(Ur + ((size_t)(g * UR_ROWS + R) * UR_LD + s * 16 + cp)) = w;
                    }
                }
            }
    }
};
struct EpiF32 {
    static constexpr bool PERM = false;
    float* C; int ldc;
    DEVI void operator()(const AccT& acc, const pg8::Unit& u, int wr, int wc, int fr, int fq) const {
        const int row0 = u.pm * 256 + wr * 64 + fr, col0 = wc * 32 + 4 * fq;
#pragma unroll
        for (int ai = 0; ai < 2; ++ai)
#pragma unroll
            for (int m = 0; m < 4; ++m) { float* rowp = C + (size_t)(row0 + ai * 128 + m * 16) * ldc + col0;
#pragma unroll
                for (int bj = 0; bj < 2; ++bj)
#pragma unroll
                    for (int n = 0; n < 2; ++n) *(f32x4*)(rowp + bj * 128 + n * 16) = acc[ai][bj][m][n]; }
    }
};
struct EpiS5Y {
    static constexpr bool PERM = true;
    bf16_t* Yg;
    DEVI void operator()(const AccT& acc, const pg8::Unit& u, int wr, int wc, int fr, int fq) const {
        const int g = u.pm / 5, pml = u.pm - g * 5, pnl = u.pn - g * 2;
        const int R0 = pml * 256 + wr * 64 + fr;
#pragma unroll
        for (int ai = 0; ai < 2; ++ai)
#pragma unroll
            for (int m = 0; m < 4; ++m) {
                const int R = R0 + ai * 128 + m * 16, b = R >> 7, k = R & 127;
#pragma unroll
                for (int bj = 0; bj < 2; ++bj) {
                    const int nl = pnl * 256 + bj * 128 + wc * 32 + 8 * fq, j = nl >> 4, cch = nl & 15;
                    float h[8];
#pragma unroll
                    for (int n = 0; n < 2; ++n)
#pragma unroll
                        for (int e = 0; e < 4; ++e) h[n * 4 + e] = gelu_tanh(acc[ai][bj][m][n][e]);
                    u32x4 w; w.x = cvt_pk_bf16(h[0], h[1]); w.y = cvt_pk_bf16(h[2], h[3]); w.z = cvt_pk_bf16(h[4], h[5]); w.w = cvt_pk_bf16(h[6], h[7]);
                    *(u32x4*)(Yg + (size_t)(b * 4096 + k * 32 + j) * 512 + g * 16 + cch) = w;
                }
            }
    }
};
struct EpiGlu {
    static constexpr bool PERM = true;
    const bf16_t* Yg; const float* bglu; bf16_t* Ycat;
    DEVI void operator()(const AccT& acc, const pg8::Unit& u, int wr, int wc, int fr, int fq) const {
        const int row0 = u.pm * 256 + wr * 64 + fr;
#pragma unroll
        for (int bj = 0; bj < 2; ++bj) {
            const int c0 = u.pn * 256 + bj * 128 + wc * 32 + 8 * fq;
            const f32x4 b0 = *(const f32x4*)(bglu + c0), b1 = *(const f32x4*)(bglu + c0 + 4);
#pragma unroll
            for (int ai = 0; ai < 2; ++ai)
#pragma unroll
                for (int m = 0; m < 4; ++m) {
                    const int r = row0 + ai * 128 + m * 16;
                    const u32x4 gw = *(const u32x4*)(Yg + (size_t)r * 512 + c0);
                    const f32x4 v0 = acc[ai][bj][m][0] + b0, v1 = acc[ai][bj][m][1] + b1;
                    float h[8];
                    h[0] = __uint_as_float(gw.x << 16) * fast_sigmoid(v0[0]); h[1] = __uint_as_float(gw.x & 0xffff0000u) * fast_sigmoid(v0[1]);
                    h[2] = __uint_as_float(gw.y << 16) * fast_sigmoid(v0[2]); h[3] = __uint_as_float(gw.y & 0xffff0000u) * fast_sigmoid(v0[3]);
                    h[4] = __uint_as_float(gw.z << 16) * fast_sigmoid(v1[0]); h[5] = __uint_as_float(gw.z & 0xffff0000u) * fast_sigmoid(v1[1]);
                    h[6] = __uint_as_float(gw.w << 16) * fast_sigmoid(v1[2]); h[7] = __uint_as_float(gw.w & 0xffff0000u) * fast_sigmoid(v1[3]);
                    u32x4 w; w.x = cvt_pk_bf16(h[0], h[1]); w.y = cvt_pk_bf16(h[2], h[3]); w.z = cvt_pk_bf16(h[4], h[5]); w.w = cvt_pk_bf16(h[6], h[7]);
                    *(u32x4*)(Ycat + (size_t)r * 1024 + 512 + c0) = w;
                }
        }
    }
};

DEVI void mod_gemv(const Params& p, float* lf) {
    const int tid = threadIdx.x;
    float* sc = lf; float* red = lf + 9 * 1024;
    for (int i = tid; i < 9 * 1024; i += 512) { const int r = i >> 10, k = i & 1023; const float v = r < 8 ? p.c[r * 1024 + k] : p.c_ctx[k]; sc[i] = v / (1.0f + __expf(-v)); }
    __syncthreads();
    for (int item = blockIdx.x; item < 288; item += gridDim.x) {
        const int cl = tid & 31, col = item * 32 + cl, kp = tid >> 5;
        float a0 = 0, a1 = 0, a2 = 0, a3 = 0, a4 = 0, a5 = 0, a6 = 0, a7 = 0, a8 = 0;
#pragma unroll 8
        for (int kk = 0; kk < 64; ++kk) { const int k = kp * 64 + kk; const float w = p.w_ada[(size_t)k * 9216 + col];
            a0 += sc[k] * w; a1 += sc[1024 + k] * w; a2 += sc[2048 + k] * w; a3 += sc[3072 + k] * w; a4 += sc[4096 + k] * w;
            a5 += sc[5120 + k] * w; a6 += sc[6144 + k] * w; a7 += sc[7168 + k] * w; a8 += sc[8192 + k] * w; }
        float* rp = red + kp * 288 + cl;
        rp[0] = a0; rp[32] = a1; rp[64] = a2; rp[96] = a3; rp[128] = a4; rp[160] = a5; rp[192] = a6; rp[224] = a7; rp[256] = a8;
        __syncthreads();
        if (tid < 288) { const int r = tid >> 5, cc = tid & 31; float s = 0.f;
#pragma unroll
            for (int q = 0; q < 16; ++q) s += red[q * 288 + r * 32 + cc];
            p.mod[r * 9216 + item * 32 + cc] = s + p.b_ada[item * 32 + cc]; }
        __syncthreads();
    }
}
DEVI void transpose_w(const float* src, bf16_t* dst, int K, int N, bool swz, float* tile  ) {
    const int tid = threadIdx.x, tn = N / 64, tk = K / 64;
    for (int t = blockIdx.x; t < tn * tk; t += gridDim.x) {
        const int n0 = (t % tn) * 64, k0 = (t / tn) * 64;
        int sc0 = n0; if (swz) { const int pn = n0 >> 8, i = n0 & 255; sc0 = (i < 128) ? pn * 128 + i : DFF + pn * 128 + (i - 128); }
        __syncthreads();
#pragma unroll
        for (int h = 0; h < 2; ++h) { const int kk = (tid >> 4) + h * 32, c4 = (tid & 15) * 4;
            const f32x4 v = *(const f32x4*)(src + (size_t)(k0 + kk) * N + sc0 + c4);
            tile[kk * 65 + c4] = v[0]; tile[kk * 65 + c4 + 1] = v[1]; tile[kk * 65 + c4 + 2] = v[2]; tile[kk * 65 + c4 + 3] = v[3]; }
        __syncthreads();
        const int n = tid >> 3, k8 = (tid & 7) * 8;
        float h[8];
#pragma unroll
        for (int e = 0; e < 8; ++e) h[e] = tile[(k8 + e) * 65 + n];
        u32x4 w; w.x = cvt_pk_bf16(h[0], h[1]); w.y = cvt_pk_bf16(h[2], h[3]); w.z = cvt_pk_bf16(h[4], h[5]); w.w = cvt_pk_bf16(h[6], h[7]);
        *(u32x4*)(dst + (size_t)(n0 + n) * K + k0 + k8) = w;
    }
}
DEVI void s5_tables(const Params& p, float* lf) {
    const int tid = threadIdx.x;
    f32x2* pw = (f32x2*)lf;
    f32x2* Cc = pw + 33 * 64;
    f32x2* Bb = Cc + 16 * 64;
    f32x2* cf = Bb + 64 * 16;
    for (int item = blockIdx.x; item < 64; item += gridDim.x) {
        const int dir = item >> 5, g = item & 31;
        __syncthreads();
        if (tid < 64) {
            const int pi = (dir * 32 + g) * 64 + tid;
            const float ar = p.a_re[pi], ai = p.a_im[pi], dt = __expf(p.log_dt[dir * 32 + g]);
            for (int e = 0; e <= 32; ++e) { const float xr = ar * dt * (float)e, yi = ai * dt * (float)e; float sn, cs; sincosf(yi, &sn, &cs); const float mg = expf(xr); pw[e * 64 + tid] = (f32x2){mg * cs, mg * sn}; }
            const float xr = ar * dt, yi = ai * dt; float sn, cs, sh, ch; sincosf(yi, &sn, &cs); sincosf(0.5f * yi, &sh, &ch);
            const float em1 = expm1f(xr), nr = em1 * cs - 2.0f * sh * sh, ni = (em1 + 1.0f) * sn;
            const float den = 1.0f / (ar * ar + ai * ai);
            cf[tid] = (f32x2){(nr * ar + ni * ai) * den, (ni * ar - nr * ai) * den};
        }
        __syncthreads();
        for (int i = tid; i < 1024; i += 512) {
            { const int pp = i >> 4; const size_t gi = ((size_t)(dir * 32 + g) * 64) * 16 + i; const float br = p.b_re[gi], bi = p.b_im[gi]; const f32x2 f = cf[pp];
              Bb[i] = (f32x2){f.x * br - f.y * bi, f.x * bi + f.y * br}; }
            { const size_t gi = ((size_t)(dir * 32 + g) * 16) * 64 + i; Cc[i] = (f32x2){p.c_re[gi], p.c_im[gi]}; }
        }
        __syncthreads();
        {
            const int cc = tid & 255, c = cc >> 4, cq = cc & 15;
            for (int tau = tid >> 8; tau < 32; tau += 2) {
                float s = 0.f;
                for (int pp = 0; pp < 64; ++pp) { const f32x2 w = pw[tau * 64 + pp], bb = Bb[pp * 16 + cq], c2 = Cc[c * 64 + pp];
                    const float mr = w.x * bb.x - w.y * bb.y, mi = w.x * bb.y + w.y * bb.x; s += c2.x * mr - c2.y * mi; }
                p.kt[((size_t)((dir * 32 + g) * 32 + tau)) * 256 + cc] = s;
            }
        }
        for (int idx = tid; idx < 128 * 512; idx += 512) {
            const int n = idx >> 9, k = idx & 511, pp = n >> 1, ri = n & 1, s = k >> 4, cq = k & 15, e = dir == 0 ? 31 - s : s;
            const f32x2 w = pw[e * 64 + pp], bb = Bb[pp * 16 + cq];
            const float v = ri == 0 ? (w.x * bb.x - w.y * bb.y) : (w.x * bb.y + w.y * bb.x);
            p.wE[(size_t)(g * 256 + dir * 128 + n) * 512 + k] = (bf16_t)(cvt_pk_bf16(v, 0.f) & 0xffffu);
        }
        for (int idx = tid; idx < 512 * 128; idx += 512) {
            const int nrow = idx >> 7, kk = idx & 127, pp = kk >> 1, ri = kk & 1, j = nrow >> 4, c = nrow & 15, e = dir == 0 ? j + 1 : 32 - j;
            const f32x2 w = pw[e * 64 + pp], c2 = Cc[c * 64 + pp];
            const float v = ri == 0 ? (c2.x * w.x - c2.y * w.y) : -(c2.x * w.y + c2.y * w.x);
            p.wY[(size_t)(g * 512 + nrow) * UR_LD + 512 + dir * 128 + kk] = (bf16_t)(cvt_pk_bf16(v, 0.f) & 0xffffu);
        }
    }
}
DEVI void toeplitz_expand(const Params& p) {
    const size_t total = (size_t)32 * 512 * 64;
    for (size_t i = (size_t)blockIdx.x * 512 + threadIdx.x; i < total; i += (size_t)gridDim.x * 512) {
        const int ko = (int)(i & 63), n = (int)((i >> 6) & 511), g = (int)(i >> 15);
        const int j = n >> 4, c = n & 15, s = ko >> 1, c0 = (ko & 1) * 8;
        float h[8];
#pragma unroll
        for (int e = 0; e < 8; ++e) h[e] = 0.f;
        if (s <= j) { const float* kp = p.kt + ((size_t)((0 * 32 + g) * 32 + (j - s))) * 256 + c * 16 + c0;
            const f32x4 v0 = *(const f32x4*)kp, v1 = *(const f32x4*)(kp + 4); h[0] += v0[0]; h[1] += v0[1]; h[2] += v0[2]; h[3] += v0[3]; h[4] += v1[0]; h[5] += v1[1]; h[6] += v1[2]; h[7] += v1[3]; }
        if (s >= j) { const float* kp = p.kt + ((size_t)((1 * 32 + g) * 32 + (s - j))) * 256 + c * 16 + c0;
            const f32x4 v0 = *(const f32x4*)kp, v1 = *(const f32x4*)(kp + 4); h[0] += v0[0]; h[1] += v0[1]; h[2] += v0[2]; h[3] += v0[3]; h[4] += v1[0]; h[5] += v1[1]; h[6] += v1[2]; h[7] += v1[3]; }
        if (s == j) { const float dv = p.s5d[g * 16 + c];
#pragma unroll
            for (int e = 0; e < 8; ++e) if (c0 + e == c) h[e] += dv; }
        u32x4 w; w.x = cvt_pk_bf16(h[0], h[1]); w.y = cvt_pk_bf16(h[2], h[3]); w.z = cvt_pk_bf16(h[4], h[5]); w.w = cvt_pk_bf16(h[6], h[7]);
        *(u32x4*)(p.wY + (size_t)(g * 512 + n) * UR_LD + s * 16 + c0) = w;
    }
}
DEVI void modulate_in(const Params& p) {
    const size_t total = (size_t)MALL * 256;
    for (size_t i = (size_t)blockIdx.x * 512 + threadIdx.x; i < total; i += (size_t)gridDim.x * 512) {
        const int r = (int)(i >> 8), c4 = (int)(i & 255) * 4;
        const float* src = r < MLAT ? p.x + (size_t)r * D : p.ctx + (size_t)(r - MLAT) * D;
        const int b = r < MLAT ? (r >> 12) : 8;
        const f32x4 v = *(const f32x4*)(src + c4), sh = *(const f32x4*)(p.mod + b * 9216 + c4), sc = *(const f32x4*)(p.mod + b * 9216 + 1024 + c4);
        const f32x4 a = v * (sc + 1.0f) + sh;
        u32x2 w; w.x = cvt_pk_bf16(a[0], a[1]); w.y = cvt_pk_bf16(a[2], a[3]);
        *(u32x2*)(p.A + (size_t)r * D + c4) = w;
    }
}
DEVI void ln_phase(const Params& p, int nrows, int lnidx, float* xout, int ctxToo, bool writeA, int seg) {
    const int tid = threadIdx.x, wid = tid >> 6, lane = tid & 63;
    const float* gp = p.ln_g + lnidx * 1024; const float* bp = p.ln_b + lnidx * 1024;
    f32x4 gv[4], bv[4];
#pragma unroll
    for (int i = 0; i < 4; ++i) { gv[i] = *(const f32x4*)(gp + i * 256 + lane * 4); bv[i] = *(const f32x4*)(bp + i * 256 + lane * 4); }
    for (int row = blockIdx.x * 8 + wid; row < nrows; row += gridDim.x * 8) {
        const float* vp = p.V + (size_t)row * D;
        f32x4 v[4];
#pragma unroll
        for (int i = 0; i < 4; ++i) v[i] = *(const f32x4*)(vp + i * 256 + lane * 4);
        float s = 0.f;
#pragma unroll
        for (int i = 0; i < 4; ++i) s += (v[i][0] + v[i][1]) + (v[i][2] + v[i][3]);
#pragma unroll
        for (int o = 32; o >= 1; o >>= 1) s += __shfl_xor(s, o);
        const float mean = s * (1.0f / 1024.0f);
        float q = 0.f;
#pragma unroll
        for (int i = 0; i < 4; ++i) { const f32x4 d = v[i] - mean; q += (d[0] * d[0] + d[1] * d[1]) + (d[2] * d[2] + d[3] * d[3]); }
#pragma unroll
        for (int o = 32; o >= 1; o >>= 1) q += __shfl_xor(q, o);
        const float rstd = rsqrtf(q * (1.0f / 1024.0f) + 1e-6f);
        const int b = row < MLAT ? (row >> 12) : 8;
        const float* mp = p.mod + b * 9216 + seg * 1024;
#pragma unroll
        for (int i = 0; i < 4; ++i) {
            const int col = i * 256 + lane * 4;
            const f32x4 xn = (v[i] - mean) * rstd * gv[i] + bv[i];
            if (xout && (ctxToo || row < MLAT)) *(f32x4*)(xout + (size_t)row * D + col) = xn;
            if (writeA) { const f32x4 sh = *(const f32x4*)(mp + col), sc = *(const f32x4*)(mp + 1024 + col); const f32x4 a = xn * (sc + 1.0f) + sh;
                u32x2 w; w.x = cvt_pk_bf16(a[0], a[1]); w.y = cvt_pk_bf16(a[2], a[3]); *(u32x2*)(p.A + (size_t)row * D + col) = w; }
        }
    }
}

constexpr int NA_PITCH = 288, NA_TILE = 64 * NA_PITCH, NA_BUF = 2 * NA_TILE, NA_RPB_OFF = 2 * NA_BUF;
DEVI void na_phase(const Params& p, LAS unsigned char* lds) {
    const int tid = threadIdx.x, wid = __builtin_amdgcn_readfirstlane(tid >> 6), lane = tid & 63, fr = lane & 15, fq = lane >> 4;
    const int hh = wid >> 2, qb = wid & 3;
    LAS float* rpbL = (LAS float*)(lds + NA_RPB_OFF);
    const int skey = tid >> 3, sch = (tid & 7) * 2;
    const int trq = (lane & 15) >> 2, trp = lane & 3;
    const float SCL = 0.125f * LOG2E;
    for (int it = blockIdx.x; it < 2048; it += gridDim.x) {
        const int r = it & 63, hp = (it >> 6) & 3, b = it >> 8;
        const int r0 = min(max(r - 4, 0), 56);
        __syncthreads();
        for (int i = tid; i < 930; i += 512) rpbL[i] = p.rpb[hp * 930 + i] * LOG2E;
        const bf16_t* qrow = p.qkv + (size_t)(b * 4096 + r * 64 + qb * 16 + fr) * 1536 + (hp * 2 + hh) * 64 + fq * 8;
        const bf16x8 qf0 = *(const bf16x8*)qrow, qf1 = *(const bf16x8*)(qrow + 32);
        u32x4 kr0, kr1, vr0, vr1;
#define NA_LOAD(i_) do { const int tok_ = (i_) < 8 ? b * 4096 + (r0 + (i_)) * 64 + skey : MLAT + b * 256 + ((i_) - 8) * 64 + skey; \
        const bf16_t* kp_ = p.qkv + (size_t)tok_ * 1536 + 512 + hp * 128 + sch * 8; \
        kr0 = *(const u32x4*)kp_; kr1 = *(const u32x4*)(kp_ + 8); vr0 = *(const u32x4*)(kp_ + 512); vr1 = *(const u32x4*)(kp_ + 520); } while (0)
#define NA_STORE(buf_) do { LAS unsigned char* d_ = lds + (buf_) * NA_BUF + skey * NA_PITCH + sch * 16; \
        *(LAS u32x4*)d_ = kr0; *(LAS u32x4*)(d_ + 16) = kr1; *(LAS u32x4*)(d_ + NA_TILE) = vr0; *(LAS u32x4*)(d_ + NA_TILE + 16) = vr1; } while (0)
        NA_LOAD(0); NA_STORE(0);
        __syncthreads();
        float m_run = -1e30f, l_run = 0.f;
        f32x4 o[4];
#pragma unroll
        for (int c = 0; c < 4; ++c) o[c] = (f32x4){0.f, 0.f, 0.f, 0.f};
        const int w = qb * 16 + fr, cs = min(max(w - 8, 0), 48);
        for (int i = 0; i < 12; ++i) {
            if (i + 1 < 12) NA_LOAD(i + 1);
            const LAS unsigned char* kb = lds + (i & 1) * NA_BUF; const LAS unsigned char* vb = kb + NA_TILE;
            f32x4 s[4];
#pragma unroll
            for (int j = 0; j < 4; ++j) {
                const LAS unsigned char* ka = kb + (16 * j + fr) * NA_PITCH + (hh * 64 + 8 * fq) * 2;
                const bf16x8 k0 = *(const LAS bf16x8*)ka, k1 = *(const LAS bf16x8*)(ka + 64);
                f32x4 a = (f32x4){0.f, 0.f, 0.f, 0.f};
                a = __builtin_amdgcn_mfma_f32_16x16x32_bf16(k0, qf0, a, 0, 0, 0);
                a = __builtin_amdgcn_mfma_f32_16x16x32_bf16(k1, qf1, a, 0, 0, 0);
                s[j] = a;
            }
            if (i < 8) {
                const LAS float* bl = rpbL + hh * 465 + (r0 + i - r + 7) * 31 - w + 15;
#pragma unroll
                for (int j = 0; j < 4; ++j)
#pragma unroll
                    for (int e = 0; e < 4; ++e) { const int kc = 16 * j + 4 * fq + e; const bool valid = (unsigned)(kc - cs) < 16u;
                        const float t = s[j][e] * SCL + bl[valid ? kc : w]; s[j][e] = valid ? t : -1e30f; }
            } else {
#pragma unroll
                for (int j = 0; j < 4; ++j) s[j] = s[j] * SCL;
            }
            float mx = -1e30f;
#pragma unroll
            for (int j = 0; j < 4; ++j) mx = fmaxf(mx, fmaxf(fmaxf(s[j][0], s[j][1]), fmaxf(s[j][2], s[j][3])));
            mx = fmaxf(mx, __shfl_xor(mx, 16)); mx = fmaxf(mx, __shfl_xor(mx, 32));
            const float mn = fmaxf(m_run, mx), al = __builtin_amdgcn_exp2f(m_run - mn); m_run = mn;
            float ps = 0.f;
#pragma unroll
            for (int j = 0; j < 4; ++j)
#pragma unroll
                for (int e = 0; e < 4; ++e) { const float pe = __builtin_amdgcn_exp2f(s[j][e] - mn); s[j][e] = pe; ps += pe; }
            ps += __shfl_xor(ps, 16); ps += __shfl_xor(ps, 32);
            l_run = l_run * al + ps;
#pragma unroll
            for (int c = 0; c < 4; ++c) o[c] = o[c] * al;
#pragma unroll
            for (int kk = 0; kk < 2; ++kk) {
                u32x4 pw; pw.x = cvt_pk_bf16(s[2 * kk][0], s[2 * kk][1]); pw.y = cvt_pk_bf16(s[2 * kk][2], s[2 * kk][3]);
                pw.z = cvt_pk_bf16(s[2 * kk + 1][0], s[2 * kk + 1][1]); pw.w = cvt_pk_bf16(s[2 * kk + 1][2], s[2 * kk + 1][3]);
                const bf16x8 pf = __builtin_bit_cast(bf16x8, pw);
#pragma unroll
                for (int c = 0; c < 4; ++c) {
                    const LAS unsigned char* va = vb + (32 * kk + 4 * fq + trq) * NA_PITCH + (hh * 64 + 16 * c + 4 * trp) * 2;
                    const s16x4 v0 = __builtin_bit_cast(s16x4, __builtin_amdgcn_ds_read_tr16_b64_v4i16((LAS s16x4*)va));
                    const s16x4 v1 = __builtin_bit_cast(s16x4, __builtin_amdgcn_ds_read_tr16_b64_v4i16((LAS s16x4*)(va + 16 * NA_PITCH)));
                    const bf16x8 vf = (bf16x8){v0[0], v0[1], v0[2], v0[3], v1[0], v1[1], v1[2], v1[3]};
                    o[c] = __builtin_amdgcn_mfma_f32_16x16x32_bf16(vf, pf, o[c], 0, 0, 0);
                }
            }
            if (i + 1 < 12) NA_STORE((i + 1) & 1);
            __syncthreads();
        }
#undef NA_LOAD
#undef NA_STORE
        const float inv = 1.0f / l_run;
        bf16_t* op = p.A + (size_t)(b * 4096 + r * 64 + qb * 16 + fr) * 1024 + (hp * 2 + hh) * 64 + 4 * fq;
#pragma unroll
        for (int c = 0; c < 4; ++c) { u32x2 w2; w2.x = cvt_pk_bf16(o[c][0] * inv, o[c][1] * inv); w2.y = cvt_pk_bf16(o[c][2] * inv, o[c][3] * inv); *(u32x2*)(op + 16 * c) = w2; }
    }
}

DEVI void s5_scan(const Params& p) {
    const int tid = threadIdx.x, wid = tid >> 6, lane = tid & 63;
    for (int w = wid * gridDim.x + blockIdx.x; w < 512; w += 8 * gridDim.x) {
        const int b = w >> 6, dir = (w >> 5) & 1, g = w & 31, pp = lane;
        const int pi = (dir * 32 + g) * 64 + pp;
        const float dt = __expf(p.log_dt[dir * 32 + g]), xr = p.a_re[pi] * dt * 32.0f, yi = p.a_im[pi] * dt * 32.0f;
        float sn, cs; sincosf(yi, &sn, &cs); const float mg = expf(xr), ar = mg * cs, ai = mg * sn;
        const float* Eb = p.E + (size_t)g * UR_ROWS * 256 + dir * 128 + pp * 2;
        bf16_t* Ub = p.Ur + (size_t)g * UR_ROWS * UR_LD + 512 + dir * 128 + pp * 2;
        float hr = 0.f, hi = 0.f;
        for (int q = 0; q < 8; ++q) { const int kc = dir == 0 ? q : 7 - q; const f32x2 e = *(const f32x2*)(Eb + (size_t)(1024 + b * 8 + kc) * 256);
            const float nr = ar * hr - ai * hi + e.x, ni = ar * hi + ai * hr + e.y; hr = nr; hi = ni; }
        for (int q0 = 0; q0 < 128; q0 += 8) {
            f32x2 ev[8];
#pragma unroll
            for (int u = 0; u < 8; ++u) { const int k = dir == 0 ? q0 + u : 127 - (q0 + u); ev[u] = *(const f32x2*)(Eb + (size_t)(b * 128 + k) * 256); }
#pragma unroll
            for (int u = 0; u < 8; ++u) { const int k = dir == 0 ? q0 + u : 127 - (q0 + u);
                *(unsigned*)(Ub + (size_t)(b * 128 + k) * UR_LD) = cvt_pk_bf16(hr, hi);
                const float nr = ar * hr - ai * hi + ev[u].x, ni = ar * hi + ai * hr + ev[u].y; hr = nr; hi = ni; }
        }
    }
}

__global__ void __launch_bounds__(512, 2) mega(Params p) {
    extern __shared__ __attribute__((aligned(16))) unsigned char smem[];
    cg::grid_group grid = cg::this_grid();
    LAS unsigned char* lds = (LAS unsigned char*)smem;
    float* lf = (float*)smem;
    const int G = gridDim.x, cid = blockIdx.x;
    const int lo = p.ph_lo, hi = p.ph_hi;
#define IN(k) (PH_ON(k) && lo <= (k) && (k) < hi)
#define SEAM(k) do { if (lo <= (k) && (k) + 1 < hi) grid.sync(); } while (0)
        if (IN(0)) {
            mod_gemv(p, lf);
            s5_tables(p, lf);
            transpose_w(p.w_up1, p.wup1t, D, 2 * DFF, true, lf);
            transpose_w(p.w_dn1, p.wdn1t, DFF, D, false, lf);
            transpose_w(p.w_in, p.wint, D, 2048, false, lf);
            transpose_w(p.w_glu, p.wglut, 512, 512, false, lf);
            transpose_w(p.w_out, p.woutt, D, D, false, lf);
            transpose_w(p.w_up2, p.wup2t, D, 2 * DFF, true, lf);
            transpose_w(p.w_dn2, p.wdn2t, DFF, D, false, lf);
        }
        SEAM(0);
        if (IN(1)) { modulate_in(p); toeplitz_expand(p); }
        SEAM(1);
        if (IN(2)) { pg8::Gemm g{p.A, p.wup1t, D, D, D}; pg8::StaticOrder S; S.init(MALL, 2 * DFF, G, cid); EpiSwiglu E{p.hid}; pg8::gemm_phase(lds, g, S, E); }
        SEAM(2);
        if (IN(3)) { pg8::Gemm g{p.hid, p.wdn1t, DFF, DFF, DFF}; pg8::StaticOrder S; S.init(MALL, D, G, cid); EpiResGate E{p.x, p.ctx, p.V, p.mod, 2, 0.5f}; pg8::gemm_phase(lds, g, S, E); }
        SEAM(3);
        if (IN(4)) ln_phase(p, MALL, 0, p.V, 0, true, 3);
        SEAM(4);
        if (IN(5)) { pg8::Gemm g{p.A, p.wint, D, D, D}; pg8::StaticOrder S; S.init(MALL, 2048, G, cid); EpiQKVU E{p.qkv, p.Ur}; pg8::gemm_phase(lds, g, S, E); }
        SEAM(5);
        if (IN(6)) {
            { pg8::Gemm g{p.Ur, p.wE, UR_LD, 512, 512}; pg8::GroupOrder S{32, 5, 1, 5, 1, G, cid}; EpiF32 E{p.E, 256}; pg8::gemm_phase(lds, g, S, E); }
            na_phase(p, lds);
        }
        SEAM(6);
        if (IN(7)) s5_scan(p);
        SEAM(7);
        if (IN(8)) { pg8::Gemm g{p.Ur, p.wY, UR_LD, UR_LD, UR_LD}; pg8::GroupOrder S{32, 4, 2, 5, 2, G, cid}; EpiS5Y E{p.qkv}; pg8::gemm_phase(lds, g, S, E); }
        SEAM(8);
        if (IN(9)) { pg8::Gemm g{p.qkv, p.wglut, 512, 512, 512}; pg8::StaticOrder S; S.init(MLAT, 512, G, cid); EpiGlu E{p.qkv, p.b_glu, p.A}; pg8::gemm_phase(lds, g, S, E); }
        SEAM(9);
        if (IN(10)) { pg8::Gemm g{p.A, p.woutt, D, D, D}; pg8::StaticOrder S; S.init(MLAT, D, G, cid); EpiResGate E{p.V, p.V, p.V, p.mod, 5, 1.0f}; pg8::gemm_phase(lds, g, S, E); }
        SEAM(10);
        if (IN(11)) ln_phase(p, MLAT, 1, p.V, 0, true, 6);
        SEAM(11);
        if (IN(12)) { pg8::Gemm g{p.A, p.wup2t, D, D, D}; pg8::StaticOrder S; S.init(MLAT, 2 * DFF, G, cid); EpiSwiglu E{p.hid}; pg8::gemm_phase(lds, g, S, E); }
        SEAM(12);
        if (IN(13)) { pg8::Gemm g{p.hid, p.wdn2t, DFF, DFF, DFF}; pg8::StaticOrder S; S.init(MLAT, D, G, cid); EpiResGate E{p.V, p.V, p.V, p.mod, 8, 0.5f}; pg8::gemm_phase(lds, g, S, E); }
        SEAM(13);
        if (IN(14)) ln_phase(p, MLAT, 2, p.out, 0, false, 0);
}

extern "C" void kernel_launch(void* const* d_in, const int* in_sizes, int n_in, void* d_out, int out_size, void* d_ws, size_t ws_size, hipStream_t stream) {
    static int grid_blocks = 0;
    if (!grid_blocks) {
        int dev = 0, cus = 0, per_cu = 0;
        hipGetDevice(&dev);
        hipDeviceGetAttribute(&cus, hipDeviceAttributeMultiprocessorCount, dev);
        hipFuncSetAttribute((const void*)mega, hipFuncAttributeMaxDynamicSharedMemorySize, LDS_BYTES);
        hipOccupancyMaxActiveBlocksPerMultiprocessor(&per_cu, (const void*)mega, 512, LDS_BYTES);
        if (per_cu < 1) { fprintf(stderr, "occupancy query reports %d blocks per CU\n", per_cu); per_cu = 1; }
        grid_blocks = cus * 1;
    }
    Params p{};
    const float* const* in = (const float* const*)d_in;
    p.x = in[0]; p.c = in[1]; p.ctx = in[2]; p.c_ctx = in[3]; p.w_ada = in[4]; p.b_ada = in[5]; p.ln_g = in[6]; p.ln_b = in[7];
    p.w_up1 = in[8]; p.w_dn1 = in[9]; p.w_in = in[10]; p.rpb = in[11]; p.a_re = in[12]; p.a_im = in[13]; p.log_dt = in[14];
    p.b_re = in[15]; p.b_im = in[16]; p.c_re = in[17]; p.c_im = in[18]; p.s5d = in[19]; p.w_glu = in[20]; p.b_glu = in[21];
    p.w_out = in[22]; p.w_up2 = in[23]; p.w_dn2 = in[24];
    p.out = (float*)d_out;
    unsigned char* ws = (unsigned char*)d_ws; size_t off = 0;
    auto take = [&](size_t bytes) { unsigned char* r = ws + off; off += (bytes + 255) & ~(size_t)255; return r; };
    p.mod = (float*)take((size_t)9 * 9216 * 4);
    p.wup1t = (bf16_t*)take((size_t)2 * DFF * D * 2); p.wdn1t = (bf16_t*)take((size_t)D * DFF * 2); p.wint = (bf16_t*)take((size_t)2048 * D * 2);
    p.wglut = (bf16_t*)take((size_t)512 * 512 * 2); p.woutt = (bf16_t*)take((size_t)D * D * 2);
    p.wup2t = (bf16_t*)take((size_t)2 * DFF * D * 2); p.wdn2t = (bf16_t*)take((size_t)D * DFF * 2);
    p.kt = (float*)take((size_t)2 * 32 * 32 * 256 * 4);
    p.wE = (bf16_t*)take((size_t)32 * 256 * 512 * 2);
    p.wY = (bf16_t*)take((size_t)32 * 512 * UR_LD * 2);
    p.A = (bf16_t*)take((size_t)MALL * D * 2);
    p.V = (float*)take((size_t)MALL * D * 4);
    p.hid = (bf16_t*)(ws + off);
    p.qkv = p.hid;
    p.Ur = (bf16_t*)((unsigned char*)p.qkv + (size_t)MALL * 1536 * 2);
    p.E = (float*)((unsigned char*)p.Ur + (size_t)32 * UR_ROWS * UR_LD * 2);
    const size_t endA = off + (size_t)MALL * DFF * 2, endB = (size_t)((unsigned char*)p.E - ws) + (size_t)32 * UR_ROWS * 256 * 4;
    if ((endA > endB ? endA : endB) > ws_size) { fprintf(stderr, "workspace too small: need %zu have %zu\n", endA > endB ? endA : endB, ws_size); return; }
#if N_LAUNCH_MODE == 1
    p.ph_lo = 0; p.ph_hi = NPHASE;
    { void* args[] = {&p}; hipError_t e = hipLaunchCooperativeKernel((void*)mega, dim3(grid_blocks), dim3(512), args, LDS_BYTES, stream);
      if (e != hipSuccess) fprintf(stderr, "cooperative launch failed: %s (grid %d)\n", hipGetErrorString(e), grid_blocks); }
#else
    for (int ph = 0; ph < NPHASE; ++ph) {
        p.ph_lo = ph; p.ph_hi = ph + 1;
        void* args[] = {&p}; hipError_t e = hipLaunchCooperativeKernel((void*)mega, dim3(grid_blocks), dim3(512), args, LDS_BYTES, stream);
        if (e != hipSuccess) { fprintf(stderr, "cooperative launch failed: %s (grid %d, phase %d)\n", hipGetErrorString(e), grid_blocks, ph); break; }
    }
#endif
}
```

```cpp
#include <hip/hip_runtime.h>
#include <hip/hip_cooperative_groups.h>
#include <cstdio>
namespace cg = cooperative_groups;

#define LAS __attribute__((address_space(3)))
#define DEVI __device__ __forceinline__
typedef unsigned short bf16_t;
typedef short bf16x8 __attribute__((ext_vector_type(8)));
typedef short s16x4 __attribute__((ext_vector_type(4)));
typedef float f32x4 __attribute__((ext_vector_type(4)));
typedef float f32x2 __attribute__((ext_vector_type(2)));
typedef unsigned u32x4 __attribute__((ext_vector_type(4)));
typedef unsigned u32x2 __attribute__((ext_vector_type(2)));

#ifndef PH_MASK
#define PH_MASK 0x7fff
#endif
#define PH_ON(k) (((PH_MASK) >> (k)) & 1)
#ifndef REP0
#define REP0 1
#endif
#ifndef REP1
#define REP1 1
#endif
#ifndef REP2
#define REP2 1
#endif
#ifndef REP3
#define REP3 1
#endif
#ifndef REP4
#define REP4 1
#endif
#ifndef REP5
#define REP5 1
#endif
#ifndef REP6
#define REP6 1
#endif
#ifndef REP7
#define REP7 1
#endif
#ifndef REP8
#define REP8 1
#endif
#ifndef REP9
#define REP9 1
#endif
#ifndef REP10
#define REP10 1
#endif
#ifndef REP11
#define REP11 1
#endif
#ifndef REP12
#define REP12 1
#endif
#ifndef REP13
#define REP13 1
#endif
#ifndef REP14
#define REP14 1
#endif
#ifndef SYNC_REP
#define SYNC_REP 1
#endif
#ifndef N_LAUNCH_MODE
#define N_LAUNCH_MODE 1
#endif

constexpr int D = 1024, SEQ = 4096, NB = 8, CTXL = 256, DFF = 2816;
constexpr int MLAT = NB * SEQ, MCTX = NB * CTXL, MALL = MLAT + MCTX;
constexpr int UR_ROWS = 1280, UR_LD = 768;
constexpr int NPHASE = 15;
constexpr float ALPHA = 1.189207115002721f;
constexpr float LOG2E = 1.4426950408889634f;
constexpr int LDS_MAIN = 131072, LDS_BYTES = LDS_MAIN + 16;

struct Params {
    const float *x, *c, *ctx, *c_ctx, *w_ada, *b_ada, *ln_g, *ln_b, *w_up1, *w_dn1, *w_in, *rpb;
    const float *a_re, *a_im, *log_dt, *b_re, *b_im, *c_re, *c_im, *s5d, *w_glu, *b_glu, *w_out, *w_up2, *w_dn2;
    float* out;
    float* mod;
    bf16_t *wup1t, *wdn1t, *wint, *wglut, *woutt, *wup2t, *wdn2t;
    float* kt;
    bf16_t* wE;
    bf16_t* wY;
    bf16_t* A;
    float* V;
    bf16_t* hid;
    bf16_t* qkv;
    bf16_t* Ur;
    float* E;
    float* stats;
    unsigned* bar;
    int ph_lo, ph_hi;
};

DEVI unsigned cvt_pk_bf16(float lo, float hi) { unsigned r; asm volatile("v_cvt_pk_bf16_f32 %0, %1, %2" : "=v"(r) : "v"(lo), "v"(hi)); return r; }
DEVI float bf2f(unsigned short b) { return __uint_as_float(((unsigned)b) << 16); }
DEVI float fast_sigmoid(float v) { return __builtin_amdgcn_rcpf(1.0f + __builtin_amdgcn_exp2f(-v * LOG2E)); }
DEVI float gelu_tanh(float v) { const float z = 0.7978845608028654f * (v + 0.044715f * v * v * v); return v * fast_sigmoid(2.0f * z); }

namespace pg8 {
constexpr int BM = 256, BK = 64, HALF = 128, HTB = HALF * BK * 2, STAGE_BYTES = 8 * HTB, NXCD = 8, WGM = 8;
DEVI int lds_byte(int r, int c) { const int st = (r >> 4) * 2 + (c >> 5), rr = r & 15, cc = c & 31, ob = rr * 64 + cc * 2; return st * 1024 + (ob ^ (((ob >> 9) & 1) << 5)); }
DEVI void stage_rc(int b, int& R, int& C) { const int st = b / 1024, sb = b % 1024, swz = sb ^ (((sb >> 9) & 1) << 5); R = (st >> 1) * 16 + swz / 64; C = (st & 1) * 32 + (swz % 64) / 2; }
DEVI int perm32(int rho) { const int n = rho >> 4, i = rho & 15; return 8 * (i >> 2) + 4 * n + (i & 3); }
struct Unit { int pm, pn; };
struct Gemm { const bf16_t* A; const bf16_t* Bt; int lda, ldb, K; };

struct StaticOrder {
    int nM, nN, nwg, G, c;
    DEVI void init(int M, int N, int G_, int c_) { nM = M / BM; nN = N / BM; nwg = nM * nN; G = G_; c = c_; }
    DEVI bool next(int i, Unit& u) const {
        const long L = (long)i * G + c; if (L >= nwg) return false;
        int wgid = (int)L; { const int q = nwg / NXCD, r = nwg % NXCD, xcd = wgid % NXCD, off = wgid / NXCD; wgid = (xcd < r ? xcd * (q + 1) : r * (q + 1) + (xcd - r) * q) + off; }
        const int nig = WGM * nN, gid = wgid / nig, fm = gid * WGM, gsz = (nM - fm) < WGM ? (nM - fm) : WGM;
        u.pm = fm + ((wgid % nig) % gsz); u.pn = (wgid % nig) / gsz; return true;
    }
    DEVI void a_ready(const Unit&) const {}
    DEVI void done(const Unit&) const {}
};
struct GroupOrder {
    int ng, mt, nt, mstride, nstride, G, c;
    DEVI bool next(int i, Unit& u) const {
        const long L = (long)i * G + c; if (L >= (long)ng * mt * nt) return false;
        const int per = mt * nt, g = (int)L / per, rem = (int)L % per;
        u.pm = g * mstride + rem % mt; u.pn = g * nstride + rem / mt; return true;
    }
    DEVI void a_ready(const Unit&) const {}
    DEVI void done(const Unit&) const {}
};

template <class Epi, class Sched>
DEVI void gemm_phase(LAS unsigned char* lds, const Gemm g, const Sched& S, const Epi& E) {
    const int tid = threadIdx.x, wid = __builtin_amdgcn_readfirstlane(tid >> 6), lane = tid & 63, wr = wid >> 2, wc = wid & 3, fr = lane & 15, fq = lane >> 4;
    const int K = g.K, nt = K / BK;
    unsigned voffA[2], voffB[2];
#pragma unroll
    for (int i = 0; i < 2; ++i) { int R, C; stage_rc(tid * 16 + i * 8192, R, C); const int Rb = Epi::PERM ? ((R & ~31) + perm32(R & 31)) : R;
        voffA[i] = (unsigned)(R * g.lda + C) * 2u; voffB[i] = (unsigned)(Rb * g.ldb + C) * 2u; }
    const size_t kstep = (size_t)(BK * 2);
    const size_t hstepA = (size_t)HALF * g.lda * 2, hstepB = (size_t)HALF * g.ldb * 2;
    const size_t tstepA = 2 * hstepA, tstepB = 2 * hstepB;
    const unsigned ldsw = (unsigned)wid * 1024u;
    const int aoff = lds_byte(wr * 64 + fr, fq * 8), boff = lds_byte(wc * 32 + fr, fq * 8);
#define PG8_SA(b, h) (((b) * 2 + (h)) * HTB)
#define PG8_SB(b, h) ((4 + (b) * 2 + (h)) * HTB)
#define PG8_STAGE(bufoff, gbase, voff) do { _Pragma("unroll") for (int _i = 0; _i < 2; ++_i) \
        __builtin_amdgcn_global_load_lds((const unsigned*)((const char*)(gbase) + (voff)[_i]), (LAS unsigned*)(lds + (bufoff) + ldsw + _i * 8192), 16, 0, 0); } while (0)
#define PG8_LDA(dst, b, h) do { _Pragma("unroll") for (int m = 0; m < 4; ++m) _Pragma("unroll") for (int k = 0; k < 2; ++k) dst[m][k] = *(const LAS bf16x8*)(lds + PG8_SA(b, h) + aoff + m * 2048 + k * 1024); } while (0)
#define PG8_LDB(dst, b, h) do { _Pragma("unroll") for (int n = 0; n < 2; ++n) _Pragma("unroll") for (int k = 0; k < 2; ++k) dst[n][k] = *(const LAS bf16x8*)(lds + PG8_SB(b, h) + boff + n * 2048 + k * 1024); } while (0)
#define PG8_MMA(ai, bj, At, Bt) do { __builtin_amdgcn_s_setprio(1); _Pragma("unroll") for (int m = 0; m < 4; ++m) _Pragma("unroll") for (int n = 0; n < 2; ++n) _Pragma("unroll") for (int k = 0; k < 2; ++k) \
        acc[ai][bj][m][n] = __builtin_amdgcn_mfma_f32_16x16x32_bf16(Bt[n][k], At[m][k], acc[ai][bj][m][n], 0, 0, 0); __builtin_amdgcn_s_setprio(0); } while (0)
#define PG8_WAIT_V(n) asm volatile("s_waitcnt vmcnt(" #n ")" ::: "memory")
#define PG8_WAIT_L(n) asm volatile("s_waitcnt lgkmcnt(" #n ")" ::: "memory")
#define PG8_BAR __builtin_amdgcn_s_barrier()
#define PG8_SCHED __builtin_amdgcn_sched_barrier(0)
    Unit cur, nxt; int ui = 0;
    if (!S.next(0, cur)) return;
    f32x4 acc[2][2][4][2];
#pragma unroll
    for (int a = 0; a < 2; ++a)
#pragma unroll
        for (int b = 0; b < 2; ++b)
#pragma unroll
            for (int m = 0; m < 4; ++m)
#pragma unroll
                for (int n = 0; n < 2; ++n) acc[a][b][m][n] = (f32x4){0.f, 0.f, 0.f, 0.f};
    bf16x8 At[4][2], B0[2][2], B1[2][2];
    const char* cA = (const char*)g.A + (size_t)cur.pm * tstepA; const char* cB = (const char*)g.Bt + (size_t)cur.pn * tstepB;
    S.a_ready(cur);
    PG8_STAGE(PG8_SB(0, 0), cB, voffB); PG8_STAGE(PG8_SA(0, 0), cA, voffA); PG8_STAGE(PG8_SB(0, 1), cB + hstepB, voffB); PG8_STAGE(PG8_SA(0, 1), cA + hstepA, voffA);
    if (wr == 1) PG8_BAR;
    PG8_WAIT_V(4); PG8_BAR;
    PG8_STAGE(PG8_SB(1, 0), cB + kstep, voffB); PG8_STAGE(PG8_SA(1, 0), cA + kstep, voffA); PG8_STAGE(PG8_SB(1, 1), cB + hstepB + kstep, voffB);
    PG8_WAIT_V(6); PG8_BAR;
    for (;;) {
        const bool has_next = S.next(ui + 1, nxt);
        const char* nA = has_next ? (const char*)g.A + (size_t)nxt.pm * tstepA : cA; const char* nB = has_next ? (const char*)g.Bt + (size_t)nxt.pn * tstepB : cB;
        for (int t = 0; t < nt; t += 2) {
            const bool last = (t == nt - 2);
            const char* a1 = cA + (size_t)(t + 1) * kstep;
            const char* a2 = last ? nA : cA + (size_t)(t + 2) * kstep; const char* b2 = last ? nB : cB + (size_t)(t + 2) * kstep;
            const char* a3 = a2 + kstep; const char* b3 = b2 + kstep;
            if (last && has_next) S.a_ready(nxt);
            PG8_LDB(B0, 0, 0); PG8_SCHED; PG8_LDA(At, 0, 0); PG8_STAGE(PG8_SA(1, 1), a1 + hstepA, voffA);
            PG8_WAIT_L(8); PG8_BAR; PG8_WAIT_L(0); PG8_MMA(0, 0, At, B0); PG8_BAR; PG8_SCHED;
            PG8_LDB(B1, 0, 1); PG8_STAGE(PG8_SB(0, 0), b2, voffB);
            PG8_BAR; PG8_WAIT_L(0); PG8_MMA(0, 1, At, B1); PG8_BAR;
            PG8_LDA(At, 0, 1); PG8_STAGE(PG8_SA(0, 0), a2, voffA);
            PG8_BAR; PG8_WAIT_L(0); PG8_MMA(1, 0, At, B0); PG8_BAR; PG8_SCHED;
            PG8_STAGE(PG8_SB(0, 1), b2 + hstepB, voffB);
            PG8_WAIT_V(6); PG8_BAR; PG8_MMA(1, 1, At, B1); PG8_BAR;
            PG8_LDB(B0, 1, 0); PG8_SCHED; PG8_LDA(At, 1, 0); PG8_STAGE(PG8_SA(0, 1), a2 + hstepA, voffA);
            PG8_WAIT_L(8); PG8_BAR; PG8_WAIT_L(0); PG8_MMA(0, 0, At, B0); PG8_BAR; PG8_SCHED;
            PG8_LDB(B1, 1, 1); PG8_STAGE(PG8_SB(1, 0), b3, voffB);
            PG8_BAR; PG8_WAIT_L(0); PG8_MMA(0, 1, At, B1); PG8_BAR;
            PG8_LDA(At, 1, 1); PG8_STAGE(PG8_SA(1, 0), a3, voffA);
            PG8_BAR; PG8_WAIT_L(0); PG8_MMA(1, 0, At, B0); PG8_BAR; PG8_SCHED;
            PG8_STAGE(PG8_SB(1, 1), b3 + hstepB, voffB);
            PG8_WAIT_V(6); PG8_BAR; PG8_MMA(1, 1, At, B1); PG8_BAR;
        }
        E(acc, cur, wr, wc, fr, fq); S.done(cur);
        if (!has_next) break;
#pragma unroll
        for (int a = 0; a < 2; ++a)
#pragma unroll
            for (int b = 0; b < 2; ++b)
#pragma unroll
                for (int m = 0; m < 4; ++m)
#pragma unroll
                    for (int n = 0; n < 2; ++n) acc[a][b][m][n] = (f32x4){0.f, 0.f, 0.f, 0.f};
        cur = nxt; cA = nA; cB = nB; ++ui;
    }
    PG8_WAIT_V(0);
    if (wr == 0) PG8_BAR;
    PG8_BAR;
#undef PG8_SA
#undef PG8_SB
#undef PG8_STAGE
#undef PG8_LDA
#undef PG8_LDB
#undef PG8_MMA
#undef PG8_WAIT_V
#undef PG8_WAIT_L
#undef PG8_BAR
#undef PG8_SCHED
}
}

typedef f32x4 AccT[2][2][4][2];

struct EpiSwiglu {
    static constexpr bool PERM = true;
    bf16_t* O;
    DEVI void operator()(const AccT& acc, const pg8::Unit& u, int wr, int wc, int fr, int fq) const {
        const int row0 = u.pm * 256 + wr * 64 + fr, col0 = u.pn * 128 + wc * 32 + 8 * fq;
#pragma unroll
        for (int ai = 0; ai < 2; ++ai)
#pragma unroll
            for (int m = 0; m < 4; ++m) {
                bf16_t* rowp = O + (size_t)(row0 + ai * 128 + m * 16) * DFF + col0;
                float h[8];
#pragma unroll
                for (int n = 0; n < 2; ++n)
#pragma unroll
                    for (int e = 0; e < 4; ++e) { const float a = acc[ai][0][m][n][e], gg = acc[ai][1][m][n][e]; h[n * 4 + e] = a * gg * fast_sigmoid(gg); }
                u32x4 w; w.x = cvt_pk_bf16(h[0], h[1]); w.y = cvt_pk_bf16(h[2], h[3]); w.z = cvt_pk_bf16(h[4], h[5]); w.w = cvt_pk_bf16(h[6], h[7]);
                *(u32x4*)rowp = w;
            }
    }
};
struct EpiResGate {
    static constexpr bool PERM = false;
    const float* resLat; const float* resCtx; float* out; const float* mod; int seg; float gs;
    DEVI void operator()(const AccT& acc, const pg8::Unit& u, int wr, int wc, int fr, int fq) const {
        const int row0 = u.pm * 256 + wr * 64 + fr, col0 = u.pn * 256 + wc * 32 + 4 * fq;
        const bool isctx = u.pm >= (MLAT / 256); const int b = isctx ? 8 : (u.pm >> 4);
        const float* gp = mod + (size_t)b * 9216 + seg * 1024 + col0;
        f32x4 gv[2][2];
#pragma unroll
        for (int bj = 0; bj < 2; ++bj)
#pragma unroll
            for (int n = 0; n < 2; ++n) gv[bj][n] = *(const f32x4*)(gp + bj * 128 + n * 16) * gs;
#pragma unroll
        for (int ai = 0; ai < 2; ++ai)
#pragma unroll
            for (int m = 0; m < 4; ++m) {
                const int r = row0 + ai * 128 + m * 16;
                const float* rp = isctx ? resCtx + (size_t)(r - MLAT) * D + col0 : resLat + (size_t)r * D + col0;
                float* op = out + (size_t)r * D + col0;
#pragma unroll
                for (int bj = 0; bj < 2; ++bj)
#pragma unroll
                    for (int n = 0; n < 2; ++n) { const f32x4 rv = *(const f32x4*)(rp + bj * 128 + n * 16); *(f32x4*)(op + bj * 128 + n * 16) = rv * ALPHA + gv[bj][n] * acc[ai][bj][m][n]; }
            }
    }
};
struct EpiLnResGate {
    static constexpr bool PERM = false;
    float* V; const float* stats; const float* lng; const float* lnb; const float* mod; int seg; float gs;
    DEVI void operator()(const AccT& acc, const pg8::Unit& u, int wr, int wc, int fr, int fq) const {
        const int row0 = u.pm * 256 + wr * 64 + fr, col0 = u.pn * 256 + wc * 32 + 4 * fq;
        const int b = u.pm >> 4;
        const float* gp = mod + (size_t)b * 9216 + seg * 1024 + col0;
        f32x4 gv[2][2], lg[2][2], lb[2][2];
#pragma unroll
        for (int bj = 0; bj < 2; ++bj)
#pragma unroll
            for (int n = 0; n < 2; ++n) { gv[bj][n] = *(const f32x4*)(gp + bj * 128 + n * 16) * gs;
                lg[bj][n] = *(const f32x4*)(lng + col0 + bj * 128 + n * 16) * ALPHA; lb[bj][n] = *(const f32x4*)(lnb + col0 + bj * 128 + n * 16) * ALPHA; }
#pragma unroll
        for (int ai = 0; ai < 2; ++ai)
#pragma unroll
            for (int m = 0; m < 4; ++m) {
                const int r = row0 + ai * 128 + m * 16;
                const f32x2 st = *(const f32x2*)(stats + (size_t)r * 2);
                float* op = V + (size_t)r * D + col0;
#pragma unroll
                for (int bj = 0; bj < 2; ++bj)
#pragma unroll
                    for (int n = 0; n < 2; ++n) { const f32x4 rv = *(const f32x4*)(op + bj * 128 + n * 16);
                        *(f32x4*)(op + bj * 128 + n * 16) = ((rv - st.x) * st.y) * lg[bj][n] + lb[bj][n] + gv[bj][n] * acc[ai][bj][m][n]; }
            }
    }
};
struct EpiQKVU {
    static constexpr bool PERM = true;
    bf16_t* qkv; bf16_t* Ur;
    DEVI void operator()(const AccT& acc, const pg8::Unit& u, int wr, int wc, int fr, int fq) const {
        const int row0 = u.pm * 256 + wr * 64 + fr;
#pragma unroll
        for (int ai = 0; ai < 2; ++ai)
#pragma unroll
            for (int m = 0; m < 4; ++m) {
                const int r = row0 + ai * 128 + m * 16;
#pragma unroll
                for (int bj = 0; bj < 2; ++bj) {
                    const f32x4 v0 = acc[ai][bj][m][0], v1 = acc[ai][bj][m][1];
                    u32x4 w; w.x = cvt_pk_bf16(v0[0], v0[1]); w.y = cvt_pk_bf16(v0[2], v0[3]); w.z = cvt_pk_bf16(v1[0], v1[1]); w.w = cvt_pk_bf16(v1[2], v1[3]);
                    if (u.pn < 6) { *(u32x4*)(qkv + (size_t)r * 1536 + u.pn * 256 + bj * 128 + wc * 32 + 8 * fq) = w; }
                    else {
                        const int ucol = (u.pn - 6) * 256 + bj * 128 + wc * 32 + 8 * fq, g = ucol >> 4, cp = ucol & 15;
                        int R, s;
                        if (r < MLAT) { const int b = r >> 12, t = r & 4095; R = b * 128 + (t >> 5); s = t & 31; }
                        else { const int rc = r - MLAT, b = rc >> 8, t = rc & 255; R = 1024 + b * 8 + (t >> 5); s = t & 31; }
                        *(u32x4*)(Ur + ((size_t)(g * UR_ROWS + R) * UR_LD + s * 16 + cp)) = w;
                    }
                }
            }
    }
};
struct EpiF32 {
    static constexpr bool PERM = false;
    float* C; int ldc;
    DEVI void operator()(const AccT& acc, const pg8::Unit& u, int wr, int wc, int fr, int fq) const {
        const int row0 = u.pm * 256 + wr * 64 + fr, col0 = wc * 32 + 4 * fq;
#pragma unroll
        for (int ai = 0; ai < 2; ++ai)
#pragma unroll
            for (int m = 0; m < 4; ++m) { float* rowp = C + (size_t)(row0 + ai * 128 + m * 16) * ldc + col0;
#pragma unroll
                for (int bj = 0; bj < 2; ++bj)
#pragma unroll
                    for (int n = 0; n < 2; ++n) *(f32x4*)(rowp + bj * 128 + n * 16) = acc[ai][bj][m][n]; }
    }
};
struct EpiS5Y {
    static constexpr bool PERM = true;
    bf16_t* Yg;
    DEVI void operator()(const AccT& acc, const pg8::Unit& u, int wr, int wc, int fr, int fq) const {
        const int g = u.pm / 5, pml = u.pm - g * 5, pnl = u.pn - g * 2;
        const int R0 = pml * 256 + wr * 64 + fr;
#pragma unroll
        for (int ai = 0; ai < 2; ++ai)
#pragma unroll
            for (int m = 0; m < 4; ++m) {
                const int R = R0 + ai * 128 + m * 16, b = R >> 7, k = R & 127;
#pragma unroll
                for (int bj = 0; bj < 2; ++bj) {
                    const int nl = pnl * 256 + bj * 128 + wc * 32 + 8 * fq, j = nl >> 4, cch = nl & 15;
                    float h[8];
#pragma unroll
                    for (int n = 0; n < 2; ++n)
#pragma unroll
                        for (int e = 0; e < 4; ++e) h[n * 4 + e] = gelu_tanh(acc[ai][bj][m][n][e]);
                    u32x4 w; w.x = cvt_pk_bf16(h[0], h[1]); w.y = cvt_pk_bf16(h[2], h[3]); w.z = cvt_pk_bf16(h[4], h[5]); w.w = cvt_pk_bf16(h[6], h[7]);
                    *(u32x4*)(Yg + (size_t)(b * 4096 + k * 32 + j) * 512 + g * 16 + cch) = w;
                }
            }
    }
};
struct EpiGlu {
    static constexpr bool PERM = true;
    const bf16_t* Yg; const float* bglu; bf16_t* Ycat;
    DEVI void operator()(const AccT& acc, const pg8::Unit& u, int wr, int wc, int fr, int fq) const {
        const int row0 = u.pm * 256 + wr * 64 + fr;
#pragma unroll
        for (int bj = 0; bj < 2; ++bj) {
            const int c0 = u.pn * 256 + bj * 128 + wc * 32 + 8 * fq;
            const f32x4 b0 = *(const f32x4*)(bglu + c0), b1 = *(const f32x4*)(bglu + c0 + 4);
#pragma unroll
            for (int ai = 0; ai < 2; ++ai)
#pragma unroll
                for (int m = 0; m < 4; ++m) {
                    const int r = row0 + ai * 128 + m * 16;
                    const u32x4 gw = *(const u32x4*)(Yg + (size_t)r * 512 + c0);
                    const f32x4 v0 = acc[ai][bj][m][0] + b0, v1 = acc[ai][bj][m][1] + b1;
                    float h[8];
                    h[0] = __uint_as_float(gw.x << 16) * fast_sigmoid(v0[0]); h[1] = __uint_as_float(gw.x & 0xffff0000u) * fast_sigmoid(v0[1]);
                    h[2] = __uint_as_float(gw.y << 16) * fast_sigmoid(v0[2]); h[3] = __uint_as_float(gw.y & 0xffff0000u) * fast_sigmoid(v0[3]);
                    h[4] = __uint_as_float(gw.z << 16) * fast_sigmoid(v1[0]); h[5] = __uint_as_float(gw.z & 0xffff0000u) * fast_sigmoid(v1[1]);
                    h[6] = __uint_as_float(gw.w << 16) * fast_sigmoid(v1[2]); h[7] = __uint_as_float(gw.w & 0xffff0000u) * fast_sigmoid(v1[3]);
                    u32x4 w; w.x = cvt_pk_bf16(h[0], h[1]); w.y = cvt_pk_bf16(h[2], h[3]); w.z = cvt_pk_bf16(h[4], h[5]); w.w = cvt_pk_bf16(h[6], h[7]);
                    *(u32x4*)(Ycat + (size_t)r * 1024 + 512 + c0) = w;
                }
        }
    }
};

DEVI void mod_gemv(const Params& p, float* lf) {
    const int tid = threadIdx.x;
    float* sc = lf; float* red = lf + 9 * 1024;
    for (int i = tid; i < 9 * 1024; i += 512) { const int r = i >> 10, k = i & 1023; const float v = r < 8 ? p.c[r * 1024 + k] : p.c_ctx[k]; sc[i] = v / (1.0f + __expf(-v)); }
    __syncthreads();
    for (int item = blockIdx.x; item < 288; item += gridDim.x) {
        const int cl = tid & 31, col = item * 32 + cl, kp = tid >> 5;
        float a0 = 0, a1 = 0, a2 = 0, a3 = 0, a4 = 0, a5 = 0, a6 = 0, a7 = 0, a8 = 0;
        float wv[64];
#pragma unroll
        for (int kk = 0; kk < 64; ++kk) wv[kk] = p.w_ada[(size_t)(kp * 64 + kk) * 9216 + col];
#pragma unroll
        for (int kk = 0; kk < 64; ++kk) { const int k = kp * 64 + kk; const float w = wv[kk];
            a0 += sc[k] * w; a1 += sc[1024 + k] * w; a2 += sc[2048 + k] * w; a3 += sc[3072 + k] * w; a4 += sc[4096 + k] * w;
            a5 += sc[5120 + k] * w; a6 += sc[6144 + k] * w; a7 += sc[7168 + k] * w; a8 += sc[8192 + k] * w; }
        float* rp = red + kp * 288 + cl;
        rp[0] = a0; rp[32] = a1; rp[64] = a2; rp[96] = a3; rp[128] = a4; rp[160] = a5; rp[192] = a6; rp[224] = a7; rp[256] = a8;
        __syncthreads();
        if (tid < 288) { const int r = tid >> 5, cc = tid & 31; float s = 0.f;
#pragma unroll
            for (int q = 0; q < 16; ++q) s += red[q * 288 + r * 32 + cc];
            p.mod[r * 9216 + item * 32 + cc] = s + p.b_ada[item * 32 + cc]; }
        __syncthreads();
    }
}
DEVI void transpose_w(const float* src, bf16_t* dst, int K, int N, bool swz, float* tile  ) {
    const int tid = threadIdx.x, tn = N / 64, tk = K / 64, ntile = tn * tk;
    for (int t0 = blockIdx.x * 4; t0 < ntile; t0 += gridDim.x * 4) {
        f32x4 v[4][2];
#pragma unroll
        for (int q = 0; q < 4; ++q) { const int t = t0 + q; if (t < ntile) {
            const int n0 = (t % tn) * 64, k0 = (t / tn) * 64;
            int sc0 = n0; if (swz) { const int pn = n0 >> 8, i = n0 & 255; sc0 = (i < 128) ? pn * 128 + i : DFF + pn * 128 + (i - 128); }
#pragma unroll
            for (int h = 0; h < 2; ++h) { const int kk = (tid >> 4) + h * 32, c4 = (tid & 15) * 4; v[q][h] = *(const f32x4*)(src + (size_t)(k0 + kk) * N + sc0 + c4); } } }
        __syncthreads();
#pragma unroll
        for (int q = 0; q < 4; ++q) { if (t0 + q < ntile) {
#pragma unroll
            for (int h = 0; h < 2; ++h) { const int kk = (tid >> 4) + h * 32, c4 = (tid & 15) * 4; float* tp = tile + q * 4160 + kk * 65 + c4;
                tp[0] = v[q][h][0]; tp[1] = v[q][h][1]; tp[2] = v[q][h][2]; tp[3] = v[q][h][3]; } } }
        __syncthreads();
#pragma unroll
        for (int q = 0; q < 4; ++q) { const int t = t0 + q; if (t < ntile) {
            const int n0 = (t % tn) * 64, k0 = (t / tn) * 64;
            const int n = tid >> 3, k8 = (tid & 7) * 8;
            float h[8];
#pragma unroll
            for (int e = 0; e < 8; ++e) h[e] = tile[q * 4160 + (k8 + e) * 65 + n];
            u32x4 w; w.x = cvt_pk_bf16(h[0], h[1]); w.y = cvt_pk_bf16(h[2], h[3]); w.z = cvt_pk_bf16(h[4], h[5]); w.w = cvt_pk_bf16(h[6], h[7]);
            *(u32x4*)(dst + (size_t)(n0 + n) * K + k0 + k8) = w; } }
    }
}
DEVI void s5_tables(const Params& p, float* lf) {
    const int tid = threadIdx.x;
    f32x2* pw = (f32x2*)lf;
    f32x2* Cc = pw + 33 * 64;
    f32x2* Bb = Cc + 16 * 64;
    f32x2* cf = Bb + 64 * 16;
    for (int item = blockIdx.x; item < 256; item += gridDim.x) {
        const int dir = item >> 7, g = (item >> 2) & 31, qt = item & 3;
        __syncthreads();
        if (tid < 64) {
            const int pi = (dir * 32 + g) * 64 + tid;
            const float ar = p.a_re[pi], ai = p.a_im[pi], dt = expf(p.log_dt[dir * 32 + g]);
            const float xr = ar * dt, yi = ai * dt; float sn, cs, sh, ch; sincosf(yi, &sn, &cs); sincosf(0.5f * yi, &sh, &ch);
            const float em1 = expm1f(xr), mg = em1 + 1.0f, abr = mg * cs, abi = mg * sn;
            float wr_ = 1.0f, wi_ = 0.0f; pw[tid] = (f32x2){1.0f, 0.0f};
            for (int e = 1; e <= 32; ++e) { const float nr_ = wr_ * abr - wi_ * abi, ni_ = wr_ * abi + wi_ * abr; wr_ = nr_; wi_ = ni_; pw[e * 64 + tid] = (f32x2){wr_, wi_}; }
            const float nr = em1 * cs - 2.0f * sh * sh, ni = mg * sn;
            const float den = 1.0f / (ar * ar + ai * ai);
            cf[tid] = (f32x2){(nr * ar + ni * ai) * den, (ni * ar - nr * ai) * den};
        }
        __syncthreads();
        for (int i = tid; i < 1024; i += 512) {
            { const int pp = i >> 4; const size_t gi = ((size_t)(dir * 32 + g) * 64) * 16 + i; const float br = p.b_re[gi], bi = p.b_im[gi]; const f32x2 f = cf[pp];
              Bb[i] = (f32x2){f.x * br - f.y * bi, f.x * bi + f.y * br}; }
            { const size_t gi = ((size_t)(dir * 32 + g) * 16) * 64 + i; Cc[i] = (f32x2){p.c_re[gi], p.c_im[gi]}; }
        }
        __syncthreads();
        {
            const int cc = tid & 255, c = cc >> 4, cq = cc & 15, tau0 = qt * 8 + (tid >> 8) * 4;
            float s0 = 0.f, s1 = 0.f, s2 = 0.f, s3 = 0.f;
            for (int pp = 0; pp < 64; ++pp) { const f32x2 bb = Bb[pp * 16 + cq], c2 = Cc[c * 64 + pp];
                const float mr = c2.x * bb.x - c2.y * bb.y, mi = c2.x * bb.y + c2.y * bb.x;
                const f32x2 w0 = pw[tau0 * 64 + pp], w1 = pw[(tau0 + 1) * 64 + pp], w2 = pw[(tau0 + 2) * 64 + pp], w3 = pw[(tau0 + 3) * 64 + pp];
                s0 += w0.x * mr - w0.y * mi; s1 += w1.x * mr - w1.y * mi; s2 += w2.x * mr - w2.y * mi; s3 += w3.x * mr - w3.y * mi; }
            float* kp = p.kt + ((size_t)((dir * 32 + g) * 32 + tau0)) * 256 + cc;
            kp[0] = s0; kp[256] = s1; kp[512] = s2; kp[768] = s3;
        }
        for (int idx = tid; idx < 32 * 512; idx += 512) {
            const int n = qt * 32 + (idx >> 9), k = idx & 511, pp = n >> 1, ri = n & 1, sI = k >> 4, cq = k & 15, e = dir == 0 ? 31 - sI : sI;
            const f32x2 w = pw[e * 64 + pp], bb = Bb[pp * 16 + cq];
            const float v = ri == 0 ? (w.x * bb.x - w.y * bb.y) : (w.x * bb.y + w.y * bb.x);
            p.wE[(size_t)(g * 256 + dir * 128 + n) * 512 + k] = (bf16_t)(cvt_pk_bf16(v, 0.f) & 0xffffu);
        }
        for (int idx = tid; idx < 128 * 128; idx += 512) {
            const int nrow = qt * 128 + (idx >> 7), kk = idx & 127, pp = kk >> 1, ri = kk & 1, j = nrow >> 4, c = nrow & 15, e = dir == 0 ? j + 1 : 32 - j;
            const f32x2 w = pw[e * 64 + pp], c2 = Cc[c * 64 + pp];
            const float v = ri == 0 ? (c2.x * w.x - c2.y * w.y) : -(c2.x * w.y + c2.y * w.x);
            p.wY[(size_t)(g * 512 + nrow) * UR_LD + 512 + dir * 128 + kk] = (bf16_t)(cvt_pk_bf16(v, 0.f) & 0xffffu);
        }
    }
}
DEVI void toeplitz_expand(const Params& p) {
    const size_t total = (size_t)32 * 512 * 64;
    for (size_t i = (size_t)blockIdx.x * 512 + threadIdx.x; i < total; i += (size_t)gridDim.x * 512) {
        const int ko = (int)(i & 63), n = (int)((i >> 6) & 511), g = (int)(i >> 15);
        const int j = n >> 4, c = n & 15, s = ko >> 1, c0 = (ko & 1) * 8;
        float h[8];
#pragma unroll
        for (int e = 0; e < 8; ++e) h[e] = 0.f;
        if (s <= j) { const float* kp = p.kt + ((size_t)((0 * 32 + g) * 32 + (j - s))) * 256 + c * 16 + c0;
            const f32x4 v0 = *(const f32x4*)kp, v1 = *(const f32x4*)(kp + 4); h[0] += v0[0]; h[1] += v0[1]; h[2] += v0[2]; h[3] += v0[3]; h[4] += v1[0]; h[5] += v1[1]; h[6] += v1[2]; h[7] += v1[3]; }
        if (s >= j) { const float* kp = p.kt + ((size_t)((1 * 32 + g) * 32 + (s - j))) * 256 + c * 16 + c0;
            const f32x4 v0 = *(const f32x4*)kp, v1 = *(const f32x4*)(kp + 4); h[0] += v0[0]; h[1] += v0[1]; h[2] += v0[2]; h[3] += v0[3]; h[4] += v1[0]; h[5] += v1[1]; h[6] += v1[2]; h[7] += v1[3]; }
        if (s == j) { const float dv = p.s5d[g * 16 + c];
#pragma unroll
            for (int e = 0; e < 8; ++e) if (c0 + e == c) h[e] += dv; }
        u32x4 w; w.x = cvt_pk_bf16(h[0], h[1]); w.y = cvt_pk_bf16(h[2], h[3]); w.z = cvt_pk_bf16(h[4], h[5]); w.w = cvt_pk_bf16(h[6], h[7]);
        *(u32x4*)(p.wY + (size_t)(g * 512 + n) * UR_LD + s * 16 + c0) = w;
    }
}
DEVI void modulate_in(const Params& p) {
    const size_t total = (size_t)MALL * 256, stride = (size_t)gridDim.x * 512;
    for (size_t i0 = (size_t)blockIdx.x * 512 + threadIdx.x; i0 < total; i0 += stride * 8) {
        f32x4 v[8];
#pragma unroll
        for (int q = 0; q < 8; ++q) { const size_t i = i0 + q * stride; if (i < total) { const int r = (int)(i >> 8), c4 = (int)(i & 255) * 4;
            const float* src = r < MLAT ? p.x + (size_t)r * D : p.ctx + (size_t)(r - MLAT) * D; v[q] = *(const f32x4*)(src + c4); } }
#pragma unroll
        for (int q = 0; q < 8; ++q) { const size_t i = i0 + q * stride; if (i < total) { const int r = (int)(i >> 8), c4 = (int)(i & 255) * 4;
            const int b = r < MLAT ? (r >> 12) : 8;
            const f32x4 sh = *(const f32x4*)(p.mod + b * 9216 + c4), sc = *(const f32x4*)(p.mod + b * 9216 + 1024 + c4);
            const f32x4 a = v[q] * (sc + 1.0f) + sh;
            u32x2 w; w.x = cvt_pk_bf16(a[0], a[1]); w.y = cvt_pk_bf16(a[2], a[3]);
            *(u32x2*)(p.A + (size_t)r * D + c4) = w; } }
    }
}
DEVI void ln_phase(const Params& p, int nrows, int lnidx, float* xout, float* stats, bool writeA, int seg) {
    const int tid = threadIdx.x, wid = tid >> 6, lane = tid & 63, W = gridDim.x * 8;
    const float* gp = p.ln_g + lnidx * 1024; const float* bp = p.ln_b + lnidx * 1024;
    f32x4 gv[4], bv[4];
#pragma unroll
    for (int i = 0; i < 4; ++i) { gv[i] = *(const f32x4*)(gp + i * 256 + lane * 4); bv[i] = *(const f32x4*)(bp + i * 256 + lane * 4); }
    for (int row0 = blockIdx.x * 8 + wid; row0 < nrows; row0 += W * 4) {
        f32x4 v[4][4];
#pragma unroll
        for (int j = 0; j < 4; ++j) { const int row = row0 + j * W; if (row < nrows) { const float* vp = p.V + (size_t)row * D;
#pragma unroll
            for (int i = 0; i < 4; ++i) v[j][i] = *(const f32x4*)(vp + i * 256 + lane * 4); } }
#pragma unroll
        for (int j = 0; j < 4; ++j) { const int row = row0 + j * W; if (row < nrows) {
            float s = 0.f;
#pragma unroll
            for (int i = 0; i < 4; ++i) s += (v[j][i][0] + v[j][i][1]) + (v[j][i][2] + v[j][i][3]);
#pragma unroll
            for (int o = 32; o >= 1; o >>= 1) s += __shfl_xor(s, o);
            const float mean = s * (1.0f / 1024.0f);
            float q = 0.f;
#pragma unroll
            for (int i = 0; i < 4; ++i) { const f32x4 d = v[j][i] - mean; q += (d[0] * d[0] + d[1] * d[1]) + (d[2] * d[2] + d[3] * d[3]); }
#pragma unroll
            for (int o = 32; o >= 1; o >>= 1) q += __shfl_xor(q, o);
            const float rstd = rsqrtf(q * (1.0f / 1024.0f) + 1e-6f);
            const int b = row < MLAT ? (row >> 12) : 8;
            const float* mp = p.mod + b * 9216 + seg * 1024;
            if (stats && lane == 0) *(f32x2*)(stats + (size_t)row * 2) = (f32x2){mean, rstd};
#pragma unroll
            for (int i = 0; i < 4; ++i) {
                const int col = i * 256 + lane * 4;
                const f32x4 xn = (v[j][i] - mean) * rstd * gv[i] + bv[i];
                if (xout) *(f32x4*)(xout + (size_t)row * D + col) = xn;
                if (writeA) { const f32x4 sh = *(const f32x4*)(mp + col), sc = *(const f32x4*)(mp + 1024 + col); const f32x4 a = xn * (sc + 1.0f) + sh;
                    u32x2 w; w.x = cvt_pk_bf16(a[0], a[1]); w.y = cvt_pk_bf16(a[2], a[3]); *(u32x2*)(p.A + (size_t)row * D + col) = w; }
            } } }
    }
}

constexpr int NA_PITCH = 288, NA_TILE = 64 * NA_PITCH, NA_BUF = 2 * NA_TILE, NA_RPB_OFF = 2 * NA_BUF;
DEVI void na_tile(const LAS unsigned char* kb, const LAS unsigned char* vb, const bool win, const LAS float* bl, const bf16x8 qf0, const bf16x8 qf1,
                  const int hh, const int fr, const int fq, const int trq, const int trp, const int w, const int cs, const int jlo, const int jhi,
                  float& m_run, float& l_run, f32x4 (&o)[4]) {
    const float SCL = 0.125f * LOG2E;
    f32x4 s[4];
#pragma unroll
    for (int j = 0; j < 4; ++j) {
        const bool act = !win || (j >= jlo && j <= jhi);
        if (act) {
            const LAS unsigned char* ka = kb + (16 * j + fr) * NA_PITCH + (hh * 64 + 8 * fq) * 2;
            const bf16x8 k0 = *(const LAS bf16x8*)ka, k1 = *(const LAS bf16x8*)(ka + 64);
            f32x4 a = (f32x4){0.f, 0.f, 0.f, 0.f};
            a = __builtin_amdgcn_mfma_f32_16x16x32_bf16(k0, qf0, a, 0, 0, 0);
            a = __builtin_amdgcn_mfma_f32_16x16x32_bf16(k1, qf1, a, 0, 0, 0);
            if (win) {
#pragma unroll
                for (int e = 0; e < 4; ++e) { const int kc = 16 * j + 4 * fq + e; const bool valid = (unsigned)(kc - cs) < 16u;
                    const float t = a[e] * SCL + bl[valid ? kc : w]; a[e] = valid ? t : -1e30f; }
            } else a = a * SCL;
            s[j] = a;
        } else s[j] = (f32x4){-1e30f, -1e30f, -1e30f, -1e30f};
    }
    float mx = -1e30f;
#pragma unroll
    for (int j = 0; j < 4; ++j) mx = fmaxf(mx, fmaxf(fmaxf(s[j][0], s[j][1]), fmaxf(s[j][2], s[j][3])));
    mx = fmaxf(mx, __shfl_xor(mx, 16)); mx = fmaxf(mx, __shfl_xor(mx, 32));
    const float mn = fmaxf(m_run, mx), al = __builtin_amdgcn_exp2f(m_run - mn); m_run = mn;
    float ps = 0.f;
#pragma unroll
    for (int j = 0; j < 4; ++j) {
        const bool act = !win || (j >= jlo && j <= jhi);
        if (act) {
#pragma unroll
            for (int e = 0; e < 4; ++e) { const float pe = __builtin_amdgcn_exp2f(s[j][e] - mn); s[j][e] = pe; ps += pe; }
        } else s[j] = (f32x4){0.f, 0.f, 0.f, 0.f};
    }
    ps += __shfl_xor(ps, 16); ps += __shfl_xor(ps, 32);
    l_run = l_run * al + ps;
#pragma unroll
    for (int c = 0; c < 4; ++c) o[c] = o[c] * al;
#pragma unroll
    for (int kk = 0; kk < 2; ++kk) {
        const bool act = !win || (kk == 0 ? jlo <= 1 : jhi >= 2);
        if (act) {
            u32x4 pw; pw.x = cvt_pk_bf16(s[2 * kk][0], s[2 * kk][1]); pw.y = cvt_pk_bf16(s[2 * kk][2], s[2 * kk][3]);
            pw.z = cvt_pk_bf16(s[2 * kk + 1][0], s[2 * kk + 1][1]); pw.w = cvt_pk_bf16(s[2 * kk + 1][2], s[2 * kk + 1][3]);
            const bf16x8 pf = __builtin_bit_cast(bf16x8, pw);
#pragma unroll
            for (int c = 0; c < 4; ++c) {
                const LAS unsigned char* va = vb + (32 * kk + 4 * fq + trq) * NA_PITCH + (hh * 64 + 16 * c + 4 * trp) * 2;
                const s16x4 v0 = __builtin_bit_cast(s16x4, __builtin_amdgcn_ds_read_tr16_b64_v4i16((LAS s16x4*)va));
                const s16x4 v1 = __builtin_bit_cast(s16x4, __builtin_amdgcn_ds_read_tr16_b64_v4i16((LAS s16x4*)(va + 16 * NA_PITCH)));
                const bf16x8 vf = (bf16x8){v0[0], v0[1], v0[2], v0[3], v1[0], v1[1], v1[2], v1[3]};
                o[c] = __builtin_amdgcn_mfma_f32_16x16x32_bf16(vf, pf, o[c], 0, 0, 0);
            }
        }
    }
}
DEVI void na_phase(const Params& p, LAS unsigned char* lds) {
    const int tid = threadIdx.x, wid = __builtin_amdgcn_readfirstlane(tid >> 6), lane = tid & 63, fr = lane & 15, fq = lane >> 4;
    const int hh = wid >> 2, qb = wid & 3;
    const int jlo = qb <= 1 ? 0 : qb - 1, jhi = qb >= 2 ? 3 : qb + 1;
    LAS float* rpbL = (LAS float*)(lds + NA_RPB_OFF);
    const int skey = tid >> 3, sch = (tid & 7) * 2;
    const int trq = (lane & 15) >> 2, trp = lane & 3;
    const int w = qb * 16 + fr, cs = min(max(w - 8, 0), 48);
    for (int it = blockIdx.x; it < 2048; it += gridDim.x) {
        int r, hp, b;
        if (gridDim.x == 256) { const int c = it & 255, xcd = c & 7; b = it >> 8; hp = xcd & 3; r = (xcd >> 2) * 32 + (c >> 3); }
        else { r = it & 63; hp = (it >> 6) & 3; b = it >> 8; }
        const int r0 = min(max(r - 4, 0), 56);
        __syncthreads();
        for (int i = tid; i < 930; i += 512) rpbL[i] = p.rpb[hp * 930 + i] * LOG2E;
        const bf16_t* qrow = p.qkv + (size_t)(b * 4096 + r * 64 + qb * 16 + fr) * 1536 + (hp * 2 + hh) * 64 + fq * 8;
        const bf16x8 qf0 = *(const bf16x8*)qrow, qf1 = *(const bf16x8*)(qrow + 32);
        u32x4 ka0, ka1, va0, va1, kb0, kb1, vb0, vb1;
#define NA_LOAD(i_, K0, K1, V0, V1) do { const int tok_ = (i_) < 8 ? b * 4096 + (r0 + (i_)) * 64 + skey : MLAT + b * 256 + ((i_) - 8) * 64 + skey; \
        const bf16_t* kp_ = p.qkv + (size_t)tok_ * 1536 + 512 + hp * 128 + sch * 8; \
        K0 = *(const u32x4*)kp_; K1 = *(const u32x4*)(kp_ + 8); V0 = *(const u32x4*)(kp_ + 512); V1 = *(const u32x4*)(kp_ + 520); } while (0)
#define NA_STORE(buf_, K0, K1, V0, V1) do { LAS unsigned char* d_ = lds + (buf_) * NA_BUF + skey * NA_PITCH + sch * 16; \
        *(LAS u32x4*)d_ = K0; *(LAS u32x4*)(d_ + 16) = K1; *(LAS u32x4*)(d_ + NA_TILE) = V0; *(LAS u32x4*)(d_ + NA_TILE + 16) = V1; } while (0)
        NA_LOAD(0, ka0, ka1, va0, va1); NA_LOAD(1, kb0, kb1, vb0, vb1);
        NA_STORE(0, ka0, ka1, va0, va1);
        __syncthreads();
        float m_run = -1e30f, l_run = 0.f;
        f32x4 o[4];
#pragma unroll
        for (int c = 0; c < 4; ++c) o[c] = (f32x4){0.f, 0.f, 0.f, 0.f};
        for (int i = 0; i < 12; i += 2) {
            if (i + 2 < 12) NA_LOAD(i + 2, ka0, ka1, va0, va1);
            na_tile(lds, lds + NA_TILE, i < 8, rpbL + hh * 465 + (r0 + i - r + 7) * 31 - w + 15, qf0, qf1, hh, fr, fq, trq, trp, w, cs, jlo, jhi, m_run, l_run, o);
            NA_STORE(1, kb0, kb1, vb0, vb1);
            __syncthreads();
            if (i + 3 < 12) NA_LOAD(i + 3, kb0, kb1, vb0, vb1);
            na_tile(lds + NA_BUF, lds + NA_BUF + NA_TILE, i + 1 < 8, rpbL + hh * 465 + (r0 + i + 1 - r + 7) * 31 - w + 15, qf0, qf1, hh, fr, fq, trq, trp, w, cs, jlo, jhi, m_run, l_run, o);
            if (i + 2 < 12) NA_STORE(0, ka0, ka1, va0, va1);
            __syncthreads();
        }
#undef NA_LOAD
#undef NA_STORE
        const float inv = 1.0f / l_run;
        bf16_t* op = p.A + (size_t)(b * 4096 + r * 64 + qb * 16 + fr) * 1024 + (hp * 2 + hh) * 64 + 4 * fq;
#pragma unroll
        for (int c = 0; c < 4; ++c) { u32x2 w2; w2.x = cvt_pk_bf16(o[c][0] * inv, o[c][1] * inv); w2.y = cvt_pk_bf16(o[c][2] * inv, o[c][3] * inv); *(u32x2*)(op + 16 * c) = w2; }
    }
}

DEVI void s5_scan(const Params& p) {
    const int tid = threadIdx.x, wid = tid >> 6, lane = tid & 63;
    for (int w = wid * gridDim.x + blockIdx.x; w < 512; w += 8 * gridDim.x) {
        const int b = w >> 6, dir = (w >> 5) & 1, g = w & 31, pp = lane;
        const int pi = (dir * 32 + g) * 64 + pp;
        const float dt = expf(p.log_dt[dir * 32 + g]), xr = p.a_re[pi] * dt * 32.0f, yi = p.a_im[pi] * dt * 32.0f;
        float sn, cs; sincosf(yi, &sn, &cs); const float mg = expf(xr), ar = mg * cs, ai = mg * sn;
        const float* Eb = p.E + (size_t)g * UR_ROWS * 256 + dir * 128 + pp * 2;
        bf16_t* Ub = p.Ur + (size_t)g * UR_ROWS * UR_LD + 512 + dir * 128 + pp * 2;
        float hr = 0.f, hi = 0.f;
        for (int q = 0; q < 8; ++q) { const int kc = dir == 0 ? q : 7 - q; const f32x2 e = *(const f32x2*)(Eb + (size_t)(1024 + b * 8 + kc) * 256);
            const float nr = ar * hr - ai * hi + e.x, ni = ar * hi + ai * hr + e.y; hr = nr; hi = ni; }
        for (int q0 = 0; q0 < 128; q0 += 8) {
            f32x2 ev[8];
#pragma unroll
            for (int u = 0; u < 8; ++u) { const int k = dir == 0 ? q0 + u : 127 - (q0 + u); ev[u] = *(const f32x2*)(Eb + (size_t)(b * 128 + k) * 256); }
#pragma unroll
            for (int u = 0; u < 8; ++u) { const int k = dir == 0 ? q0 + u : 127 - (q0 + u);
                *(unsigned*)(Ub + (size_t)(b * 128 + k) * UR_LD) = cvt_pk_bf16(hr, hi);
                const float nr = ar * hr - ai * hi + ev[u].x, ni = ar * hi + ai * hr + ev[u].y; hr = nr; hi = ni; }
        }
    }
}


#define XB_TMO      128
#define XB_XCNT(j)  (256  + 64 * (j))
#define XB_XSUB(j)  (1280 + 64 * (j))
#define XB_XGEN(j)  (2304 + 64 * (j))
#define XB_TOP      3328
#define XB_TOPGEN   3392
#define XCD_BAR_WORDS 3456
#define XB_SPIN_CAP (1u << 22)
DEVI unsigned xb_ld(unsigned* p)              { return __hip_atomic_load(p, __ATOMIC_RELAXED, __HIP_MEMORY_SCOPE_AGENT); }
DEVI unsigned xb_add(unsigned* p, unsigned v) { return __hip_atomic_fetch_add(p, v, __ATOMIC_RELAXED, __HIP_MEMORY_SCOPE_AGENT); }
DEVI unsigned xb_xcc_id() { return (unsigned)__builtin_amdgcn_s_getreg((3 << 11) | 20) & 0xFu; }
#define XB_SPIN(cond, bar) do { unsigned _sp = 0; while (cond) { __builtin_amdgcn_s_sleep(1); \
    if ((++_sp & 255u) == 0u) { if (xb_ld(&(bar)[XB_TMO])) break; if (_sp > XB_SPIN_CAP) { atomicAdd(&(bar)[XB_TMO], 1u); break; } } } } while (0)
struct XcdBarrier { unsigned* bar; unsigned x; volatile LAS unsigned* st; };
DEVI XcdBarrier xcd_barrier_post(unsigned* bar, volatile LAS unsigned* st) {
    XcdBarrier b; b.bar = bar; b.x = xb_xcc_id(); b.st = st;
    if (threadIdx.x == 0) (void)xb_add(&bar[XB_XCNT(b.x)], 1u);
    return b;
}
DEVI void xcd_barrier_complete(unsigned* bar, unsigned x, unsigned& nloc, unsigned& nx) {
    const unsigned G = gridDim.x * gridDim.y * gridDim.z;
    unsigned sum, cnt, mine, sp = 0u;
    for (;;) {
        sum = 0u; cnt = 0u; mine = 0u;
#pragma unroll
        for (unsigned j = 0; j < 16; ++j) { const unsigned c = xb_ld(&bar[XB_XCNT(j)]); sum += c; cnt += (c > 0u) ? 1u : 0u; mine = (j == x) ? c : mine; }
        if (sum == G) break;
        __builtin_amdgcn_s_sleep(1);
        if ((++sp & 255u) == 0u) { if (xb_ld(&bar[XB_TMO])) break; if (sp > XB_SPIN_CAP) { atomicAdd(&bar[XB_TMO], 1u); break; } }
    }
    nloc = mine > 0u ? mine : 1u; nx = cnt > 0u ? cnt : 1u;
}
DEVI void xcd_barrier(const XcdBarrier& b) {
    asm volatile("s_waitcnt vmcnt(0)" ::: "memory");
    __syncthreads();
    if (threadIdx.x == 0) {
        unsigned* bar = b.bar;
        __builtin_amdgcn_s_waitcnt(0);
        unsigned nloc = b.st[0], nx = b.st[1];
        if (nloc == 0u) { xcd_barrier_complete(bar, b.x, nloc, nx); b.st[0] = nloc; b.st[1] = nx; }
        const unsigned old = xb_add(&bar[XB_XSUB(b.x)], 1u);
        const unsigned gen = old / nloc;
        if (old + 1u == (gen + 1u) * nloc) {
            __builtin_amdgcn_fence(__ATOMIC_RELEASE, "agent");
            asm volatile("s_waitcnt vmcnt(0)" ::: "memory");
            const unsigned og = xb_add(&bar[XB_TOP], 1u);
            const unsigned tg = og / nx;
            if (og + 1u == (tg + 1u) * nx) xb_add(&bar[XB_TOPGEN], 1u);
            else XB_SPIN(xb_ld(&bar[XB_TOPGEN]) == tg, bar);
            __builtin_amdgcn_fence(__ATOMIC_ACQUIRE, "agent");
            xb_add(&bar[XB_XGEN(b.x)], 1u);
            asm volatile("s_waitcnt vmcnt(0)" ::: "memory");
        } else {
            XB_SPIN(xb_ld(&bar[XB_XGEN(b.x)]) == gen, bar);
            __builtin_amdgcn_fence(__ATOMIC_ACQUIRE, "agent");
            asm volatile("s_waitcnt vmcnt(0)" ::: "memory");
        }
    }
    __syncthreads();
}

__global__ void __launch_bounds__(512, 2) mega(Params p) {
    extern __shared__ __attribute__((aligned(16))) unsigned char smem[];
    cg::grid_group grid = cg::this_grid();
    LAS unsigned char* lds = (LAS unsigned char*)smem;
    float* lf = (float*)smem;
    const int G = gridDim.x, cid = blockIdx.x;
    const int lo = p.ph_lo, hi = p.ph_hi;
    volatile LAS unsigned* xst = (volatile LAS unsigned*)(lds + LDS_MAIN);
    if (threadIdx.x < 4) xst[threadIdx.x] = 0u;
    __syncthreads();
    XcdBarrier xb; xb.bar = p.bar; xb.x = 0; xb.st = xst;
    if (hi - lo > 1) xb = xcd_barrier_post(p.bar, xst);
    if (lo < 0) grid.sync();
#define IN(k) (PH_ON(k) && lo <= (k) && (k) < hi)
#define SEAM(k) do { if (lo <= (k) && (k) + 1 < hi) { for (int sr_ = 0; sr_ < SYNC_REP; ++sr_) { xcd_barrier(xb); } } } while (0)
        if (IN(0)) for (int rep_ = 0; rep_ < REP0; ++rep_) {
            mod_gemv(p, lf);
            s5_tables(p, lf);
            transpose_w(p.w_up1, p.wup1t, D, 2 * DFF, true, lf);
            transpose_w(p.w_dn1, p.wdn1t, DFF, D, false, lf);
            transpose_w(p.w_in, p.wint, D, 2048, false, lf);
            transpose_w(p.w_glu, p.wglut, 512, 512, false, lf);
            transpose_w(p.w_out, p.woutt, D, D, false, lf);
            transpose_w(p.w_up2, p.wup2t, D, 2 * DFF, true, lf);
            transpose_w(p.w_dn2, p.wdn2t, DFF, D, false, lf);
        }
        SEAM(0);
        if (IN(1)) for (int rep_ = 0; rep_ < REP1; ++rep_) { modulate_in(p); toeplitz_expand(p); }
        SEAM(1);
        if (IN(2)) for (int rep_ = 0; rep_ < REP2; ++rep_) { pg8::Gemm g{p.A, p.wup1t, D, D, D}; pg8::StaticOrder S; S.init(MALL, 2 * DFF, G, cid); EpiSwiglu E{p.hid}; pg8::gemm_phase(lds, g, S, E); }
        SEAM(2);
        if (IN(3)) for (int rep_ = 0; rep_ < REP3; ++rep_) { pg8::Gemm g{p.hid, p.wdn1t, DFF, DFF, DFF}; pg8::StaticOrder S; S.init(MALL, D, G, cid); EpiResGate E{p.x, p.ctx, p.V, p.mod, 2, 0.5f}; pg8::gemm_phase(lds, g, S, E); }
        SEAM(3);
        if (IN(4)) for (int rep_ = 0; rep_ < REP4; ++rep_) ln_phase(p, MALL, 0, nullptr, p.stats, true, 3);
        SEAM(4);
        if (IN(5)) for (int rep_ = 0; rep_ < REP5; ++rep_) { pg8::Gemm g{p.A, p.wint, D, D, D}; pg8::StaticOrder S; S.init(MALL, 2048, G, cid); EpiQKVU E{p.qkv, p.Ur}; pg8::gemm_phase(lds, g, S, E); }
        SEAM(5);
        if (IN(6)) {
            { pg8::Gemm g{p.Ur, p.wE, UR_LD, 512, 512}; pg8::GroupOrder S{32, 5, 1, 5, 1, G, cid}; EpiF32 E{p.E, 256}; pg8::gemm_phase(lds, g, S, E); }
            for (int rep_ = 0; rep_ < REP6; ++rep_) na_phase(p, lds);
        }
        SEAM(6);
        if (IN(7)) for (int rep_ = 0; rep_ < REP7; ++rep_) s5_scan(p);
        SEAM(7);
        if (IN(8)) for (int rep_ = 0; rep_ < REP8; ++rep_) { pg8::Gemm g{p.Ur, p.wY, UR_LD, UR_LD, UR_LD}; pg8::GroupOrder S{32, 4, 2, 5, 2, G, cid}; EpiS5Y E{p.qkv}; pg8::gemm_phase(lds, g, S, E); }
        SEAM(8);
        if (IN(9)) for (int rep_ = 0; rep_ < REP9; ++rep_) { pg8::Gemm g{p.qkv, p.wglut, 512, 512, 512}; pg8::StaticOrder S; S.init(MLAT, 512, G, cid); EpiGlu E{p.qkv, p.b_glu, p.A}; pg8::gemm_phase(lds, g, S, E); }
        SEAM(9);
        if (IN(10)) { pg8::Gemm g{p.A, p.woutt, D, D, D}; pg8::StaticOrder S; S.init(MLAT, D, G, cid); EpiLnResGate E{p.V, p.stats, p.ln_g, p.ln_b, p.mod, 5, 1.0f}; pg8::gemm_phase(lds, g, S, E); }
        SEAM(10);
        if (IN(11)) for (int rep_ = 0; rep_ < REP11; ++rep_) ln_phase(p, MLAT, 1, nullptr, p.stats, true, 6);
        SEAM(11);
        if (IN(12)) for (int rep_ = 0; rep_ < REP12; ++rep_) { pg8::Gemm g{p.A, p.wup2t, D, D, D}; pg8::StaticOrder S; S.init(MLAT, 2 * DFF, G, cid); EpiSwiglu E{p.hid}; pg8::gemm_phase(lds, g, S, E); }
        SEAM(12);
        if (IN(13)) { pg8::Gemm g{p.hid, p.wdn2t, DFF, DFF, DFF}; pg8::StaticOrder S; S.init(MLAT, D, G, cid); EpiLnResGate E{p.V, p.stats, p.ln_g + 1024, p.ln_b + 1024, p.mod, 8, 0.5f}; pg8::gemm_phase(lds, g, S, E); }
        SEAM(13);
        if (IN(14)) for (int rep_ = 0; rep_ < REP14; ++rep_) ln_phase(p, MLAT, 2, p.out, nullptr, false, 0);
}

extern "C" void kernel_launch(void* const* d_in, const int* in_sizes, int n_in, void* d_out, int out_size, void* d_ws, size_t ws_size, hipStream_t stream) {
    static int grid_blocks = 0;
    if (!grid_blocks) {
        int dev = 0, cus = 0, per_cu = 0;
        hipGetDevice(&dev);
        hipDeviceGetAttribute(&cus, hipDeviceAttributeMultiprocessorCount, dev);
        hipFuncSetAttribute((const void*)mega, hipFuncAttributeMaxDynamicSharedMemorySize, LDS_BYTES);
        hipOccupancyMaxActiveBlocksPerMultiprocessor(&per_cu, (const void*)mega, 512, LDS_BYTES);
        if (per_cu < 1) { fprintf(stderr, "occupancy query reports %d blocks per CU\n", per_cu); per_cu = 1; }
        grid_blocks = cus * 1;
    }
    Params p{};
    const float* const* in = (const float* const*)d_in;
    p.x = in[0]; p.c = in[1]; p.ctx = in[2]; p.c_ctx = in[3]; p.w_ada = in[4]; p.b_ada = in[5]; p.ln_g = in[6]; p.ln_b = in[7];
    p.w_up1 = in[8]; p.w_dn1 = in[9]; p.w_in = in[10]; p.rpb = in[11]; p.a_re = in[12]; p.a_im = in[13]; p.log_dt = in[14];
    p.b_re = in[15]; p.b_im = in[16]; p.c_re = in[17]; p.c_im = in[18]; p.s5d = in[19]; p.w_glu = in[20]; p.b_glu = in[21];
    p.w_out = in[22]; p.w_up2 = in[23]; p.w_dn2 = in[24];
    p.out = (float*)d_out;
    unsigned char* ws = (unsigned char*)d_ws; size_t off = 0;
    auto take = [&](size_t bytes) { unsigned char* r = ws + off; off += (bytes + 255) & ~(size_t)255; return r; };
    p.bar = (unsigned*)take((size_t)XCD_BAR_WORDS * 4);
    p.mod = (float*)take((size_t)9 * 9216 * 4);
    p.stats = (float*)take((size_t)MALL * 2 * 4);
    p.wup1t = (bf16_t*)take((size_t)2 * DFF * D * 2); p.wdn1t = (bf16_t*)take((size_t)D * DFF * 2); p.wint = (bf16_t*)take((size_t)2048 * D * 2);
    p.wglut = (bf16_t*)take((size_t)512 * 512 * 2); p.woutt = (bf16_t*)take((size_t)D * D * 2);
    p.wup2t = (bf16_t*)take((size_t)2 * DFF * D * 2); p.wdn2t = (bf16_t*)take((size_t)D * DFF * 2);
    p.kt = (float*)take((size_t)2 * 32 * 32 * 256 * 4);
    p.wE = (bf16_t*)take((size_t)32 * 256 * 512 * 2);
    p.wY = (bf16_t*)take((size_t)32 * 512 * UR_LD * 2);
    p.A = (bf16_t*)take((size_t)MALL * D * 2);
    p.V = (float*)take((size_t)MALL * D * 4);
    p.hid = (bf16_t*)(ws + off);
    p.qkv = p.hid;
    p.Ur = (bf16_t*)((unsigned char*)p.qkv + (size_t)MALL * 1536 * 2);
    p.E = (float*)((unsigned char*)p.Ur + (size_t)32 * UR_ROWS * UR_LD * 2);
    const size_t endA = off + (size_t)MALL * DFF * 2, endB = (size_t)((unsigned char*)p.E - ws) + (size_t)32 * UR_ROWS * 256 * 4;
    if ((endA > endB ? endA : endB) > ws_size) { fprintf(stderr, "workspace too small: need %zu have %zu\n", endA > endB ? endA : endB, ws_size); return; }
#if N_LAUNCH_MODE == 1
    p.ph_lo = 0; p.ph_hi = NPHASE;
    if (hipMemsetAsync(p.bar, 0, (size_t)XCD_BAR_WORDS * 4, stream) != hipSuccess) { fprintf(stderr, "memset of barrier words failed\n"); return; }
    { void* args[] = {&p}; hipError_t e = hipLaunchCooperativeKernel((void*)mega, dim3(grid_blocks), dim3(512), args, LDS_BYTES, stream);
      if (e != hipSuccess) fprintf(stderr, "cooperative launch failed: %s (grid %d)\n", hipGetErrorString(e), grid_blocks); }
#else
    for (int ph = 0; ph < NPHASE; ++ph) {
        p.ph_lo = ph; p.ph_hi = ph + 1;
        void* args[] = {&p}; hipError_t e = hipLaunchCooperativeKernel((void*)mega, dim3(grid_blocks), dim3(512), args, LDS_BYTES, stream);
        if (e != hipSuccess) { fprintf(stderr, "cooperative launch failed: %s (grid %d, phase %d)\n", hipGetErrorString(e), grid_blocks, ph); break; }
    }
#endif
}
```

```cpp
#include <hip/hip_runtime.h>
#include <hip/hip_cooperative_groups.h>
#include <cstdio>
namespace cg = cooperative_groups;

#define LAS __attribute__((address_space(3)))
#define DEVI __device__ __forceinline__
typedef unsigned short bf16_t;
typedef short bf16x8 __attribute__((ext_vector_type(8)));
typedef short s16x4 __attribute__((ext_vector_type(4)));
typedef float f32x4 __attribute__((ext_vector_type(4)));
typedef float f32x2 __attribute__((ext_vector_type(2)));
typedef unsigned u32x4 __attribute__((ext_vector_type(4)));
typedef unsigned u32x2 __attribute__((ext_vector_type(2)));

#ifndef PH_MASK
#define PH_MASK 0xffff
#endif
#define PH_ON(k) (((PH_MASK) >> (k)) & 1)
#ifndef REP0
#define REP0 1
#endif
#ifndef REP1
#define REP1 1
#endif
#ifndef REP2
#define REP2 1
#endif
#ifndef REP3
#define REP3 1
#endif
#ifndef REP4
#define REP4 1
#endif
#ifndef REP5
#define REP5 1
#endif
#ifndef REP6
#define REP6 1
#endif
#ifndef REP7
#define REP7 1
#endif
#ifndef REP8
#define REP8 1
#endif
#ifndef REP9
#define REP9 1
#endif
#ifndef REP10
#define REP10 1
#endif
#ifndef REP11
#define REP11 1
#endif
#ifndef REP12
#define REP12 1
#endif
#ifndef REP13
#define REP13 1
#endif
#ifndef REP14
#define REP14 1
#endif
#ifndef REP15
#define REP15 1
#endif
#ifndef SYNC_REP
#define SYNC_REP 1
#endif
#ifndef N_LAUNCH_MODE
#define N_LAUNCH_MODE 1
#endif

constexpr int D = 1024, SEQ = 4096, NB = 8, CTXL = 256, DFF = 2816;
constexpr int MLAT = NB * SEQ, MCTX = NB * CTXL, MALL = MLAT + MCTX;
constexpr int UR_ROWS = 1280, UR_LD = 768;
constexpr int NPHASE = 16;
constexpr float ALPHA = 1.189207115002721f;
constexpr float LOG2E = 1.4426950408889634f;
constexpr int LDS_MAIN = 131072, LDS_BYTES = LDS_MAIN + 16;

struct Params {
    const float *x, *c, *ctx, *c_ctx, *w_ada, *b_ada, *ln_g, *ln_b, *w_up1, *w_dn1, *w_in, *rpb;
    const float *a_re, *a_im, *log_dt, *b_re, *b_im, *c_re, *c_im, *s5d, *w_glu, *b_glu, *w_out, *w_up2, *w_dn2;
    float* out;
    float* mod;
    bf16_t *wup1t, *wdn1t, *wint, *wglut, *woutt, *wup2t, *wdn2t;
    float* kt;
    bf16_t* wE;
    bf16_t* wY;
    bf16_t* A;
    float* V;
    bf16_t* hid;
    bf16_t* qkv;
    bf16_t* Ur;
    float* E;
    float* stats;
    unsigned* bar;
    int ph_lo, ph_hi;
};

DEVI unsigned cvt_pk_bf16(float lo, float hi) { unsigned r; asm volatile("v_cvt_pk_bf16_f32 %0, %1, %2" : "=v"(r) : "v"(lo), "v"(hi)); return r; }
DEVI float bf2f(unsigned short b) { return __uint_as_float(((unsigned)b) << 16); }
DEVI float fast_sigmoid(float v) { return __builtin_amdgcn_rcpf(1.0f + __builtin_amdgcn_exp2f(-v * LOG2E)); }
DEVI float gelu_tanh(float v) { const float z = 0.7978845608028654f * (v + 0.044715f * v * v * v); return v * fast_sigmoid(2.0f * z); }

namespace pg8 {
constexpr int BM = 256, BK = 64, HALF = 128, HTB = HALF * BK * 2, STAGE_BYTES = 8 * HTB, NXCD = 8, WGM = 8;
DEVI int lds_byte(int r, int c) { const int st = (r >> 4) * 2 + (c >> 5), rr = r & 15, cc = c & 31, ob = rr * 64 + cc * 2; return st * 1024 + (ob ^ (((ob >> 9) & 1) << 5)); }
DEVI void stage_rc(int b, int& R, int& C) { const int st = b / 1024, sb = b % 1024, swz = sb ^ (((sb >> 9) & 1) << 5); R = (st >> 1) * 16 + swz / 64; C = (st & 1) * 32 + (swz % 64) / 2; }
DEVI int perm32(int rho) { const int n = rho >> 4, i = rho & 15; return 8 * (i >> 2) + 4 * n + (i & 3); }
struct Unit { int pm, pn; };
struct Gemm { const bf16_t* A; const bf16_t* Bt; int lda, ldb, K; };

struct StaticOrder {
    int nM, nN, nwg, G, c;
    DEVI void init(int M, int N, int G_, int c_) { nM = M / BM; nN = N / BM; nwg = nM * nN; G = G_; c = c_; }
    DEVI bool next(int i, Unit& u) const {
        const long L = (long)i * G + c; if (L >= nwg) return false;
        int wgid = (int)L; { const int q = nwg / NXCD, r = nwg % NXCD, xcd = wgid % NXCD, off = wgid / NXCD; wgid = (xcd < r ? xcd * (q + 1) : r * (q + 1) + (xcd - r) * q) + off; }
        const int nig = WGM * nN, gid = wgid / nig, fm = gid * WGM, gsz = (nM - fm) < WGM ? (nM - fm) : WGM;
        u.pm = fm + ((wgid % nig) % gsz); u.pn = (wgid % nig) / gsz; return true;
    }
    DEVI void a_ready(const Unit&) const {}
    DEVI void done(const Unit&) const {}
};
struct GroupOrder {
    int ng, mt, nt, mstride, nstride, G, c, pm0;
    DEVI bool next(int i, Unit& u) const {
        const long L = (long)i * G + c; if (L >= (long)ng * mt * nt) return false;
        const int per = mt * nt, g = (int)L / per, rem = (int)L % per;
        u.pm = pm0 + g * mstride + rem % mt; u.pn = g * nstride + rem / mt; return true;
    }
    DEVI void a_ready(const Unit&) const {}
    DEVI void done(const Unit&) const {}
};

template <class Epi, class Sched>
DEVI void gemm_phase(LAS unsigned char* lds, const Gemm g, const Sched& S, const Epi& E) {
    const int tid = threadIdx.x, wid = __builtin_amdgcn_readfirstlane(tid >> 6), lane = tid & 63, wr = wid >> 2, wc = wid & 3, fr = lane & 15, fq = lane >> 4;
    const int K = g.K, nt = K / BK;
    unsigned voffA[2], voffB[2];
#pragma unroll
    for (int i = 0; i < 2; ++i) { int R, C; stage_rc(tid * 16 + i * 8192, R, C); const int Rb = Epi::PERM ? ((R & ~31) + perm32(R & 31)) : R;
        voffA[i] = (unsigned)(R * g.lda + C) * 2u; voffB[i] = (unsigned)(Rb * g.ldb + C) * 2u; }
    const size_t kstep = (size_t)(BK * 2);
    const size_t hstepA = (size_t)HALF * g.lda * 2, hstepB = (size_t)HALF * g.ldb * 2;
    const size_t tstepA = 2 * hstepA, tstepB = 2 * hstepB;
    const unsigned ldsw = (unsigned)wid * 1024u;
    const int aoff = lds_byte(wr * 64 + fr, fq * 8), boff = lds_byte(wc * 32 + fr, fq * 8);
#define PG8_SA(b, h) (((b) * 2 + (h)) * HTB)
#define PG8_SB(b, h) ((4 + (b) * 2 + (h)) * HTB)
#define PG8_STAGE(bufoff, gbase, voff) do { _Pragma("unroll") for (int _i = 0; _i < 2; ++_i) \
        __builtin_amdgcn_global_load_lds((const unsigned*)((const char*)(gbase) + (voff)[_i]), (LAS unsigned*)(lds + (bufoff) + ldsw + _i * 8192), 16, 0, 0); } while (0)
#define PG8_LDA(dst, b, h) do { _Pragma("unroll") for (int m = 0; m < 4; ++m) _Pragma("unroll") for (int k = 0; k < 2; ++k) dst[m][k] = *(const LAS bf16x8*)(lds + PG8_SA(b, h) + aoff + m * 2048 + k * 1024); } while (0)
#define PG8_LDB(dst, b, h) do { _Pragma("unroll") for (int n = 0; n < 2; ++n) _Pragma("unroll") for (int k = 0; k < 2; ++k) dst[n][k] = *(const LAS bf16x8*)(lds + PG8_SB(b, h) + boff + n * 2048 + k * 1024); } while (0)
#define PG8_MMA(ai, bj, At, Bt) do { __builtin_amdgcn_s_setprio(1); _Pragma("unroll") for (int m = 0; m < 4; ++m) _Pragma("unroll") for (int n = 0; n < 2; ++n) _Pragma("unroll") for (int k = 0; k < 2; ++k) \
        acc[ai][bj][m][n] = __builtin_amdgcn_mfma_f32_16x16x32_bf16(Bt[n][k], At[m][k], acc[ai][bj][m][n], 0, 0, 0); __builtin_amdgcn_s_setprio(0); } while (0)
#define PG8_WAIT_V(n) asm volatile("s_waitcnt vmcnt(" #n ")" ::: "memory")
#define PG8_WAIT_L(n) asm volatile("s_waitcnt lgkmcnt(" #n ")" ::: "memory")
#define PG8_BAR __builtin_amdgcn_s_barrier()
#define PG8_SCHED __builtin_amdgcn_sched_barrier(0)
    Unit cur, nxt; int ui = 0;
    if (!S.next(0, cur)) return;
    f32x4 acc[2][2][4][2];
#pragma unroll
    for (int a = 0; a < 2; ++a)
#pragma unroll
        for (int b = 0; b < 2; ++b)
#pragma unroll
            for (int m = 0; m < 4; ++m)
#pragma unroll
                for (int n = 0; n < 2; ++n) acc[a][b][m][n] = (f32x4){0.f, 0.f, 0.f, 0.f};
    bf16x8 At[4][2], B0[2][2], B1[2][2];
    const char* cA = (const char*)g.A + (size_t)cur.pm * tstepA; const char* cB = (const char*)g.Bt + (size_t)cur.pn * tstepB;
    S.a_ready(cur);
    PG8_STAGE(PG8_SB(0, 0), cB, voffB); PG8_STAGE(PG8_SA(0, 0), cA, voffA); PG8_STAGE(PG8_SB(0, 1), cB + hstepB, voffB); PG8_STAGE(PG8_SA(0, 1), cA + hstepA, voffA);
    if (wr == 1) PG8_BAR;
    PG8_WAIT_V(4); PG8_BAR;
    PG8_STAGE(PG8_SB(1, 0), cB + kstep, voffB); PG8_STAGE(PG8_SA(1, 0), cA + kstep, voffA); PG8_STAGE(PG8_SB(1, 1), cB + hstepB + kstep, voffB);
    PG8_WAIT_V(6); PG8_BAR;
    for (;;) {
        const bool has_next = S.next(ui + 1, nxt);
        const char* nA = has_next ? (const char*)g.A + (size_t)nxt.pm * tstepA : cA; const char* nB = has_next ? (const char*)g.Bt + (size_t)nxt.pn * tstepB : cB;
        for (int t = 0; t < nt; t += 2) {
            const bool last = (t == nt - 2);
            const char* a1 = cA + (size_t)(t + 1) * kstep;
            const char* a2 = last ? nA : cA + (size_t)(t + 2) * kstep; const char* b2 = last ? nB : cB + (size_t)(t + 2) * kstep;
            const char* a3 = a2 + kstep; const char* b3 = b2 + kstep;
            if (last && has_next) S.a_ready(nxt);
            PG8_LDB(B0, 0, 0); PG8_SCHED; PG8_LDA(At, 0, 0); PG8_STAGE(PG8_SA(1, 1), a1 + hstepA, voffA);
            PG8_WAIT_L(8); PG8_BAR; PG8_WAIT_L(0); PG8_MMA(0, 0, At, B0); PG8_BAR; PG8_SCHED;
            PG8_LDB(B1, 0, 1); PG8_STAGE(PG8_SB(0, 0), b2, voffB);
            PG8_BAR; PG8_WAIT_L(0); PG8_MMA(0, 1, At, B1); PG8_BAR;
            PG8_LDA(At, 0, 1); PG8_STAGE(PG8_SA(0, 0), a2, voffA);
            PG8_BAR; PG8_WAIT_L(0); PG8_MMA(1, 0, At, B0); PG8_BAR; PG8_SCHED;
            PG8_STAGE(PG8_SB(0, 1), b2 + hstepB, voffB);
            PG8_WAIT_V(6); PG8_BAR; PG8_MMA(1, 1, At, B1); PG8_BAR;
            PG8_LDB(B0, 1, 0); PG8_SCHED; PG8_LDA(At, 1, 0); PG8_STAGE(PG8_SA(0, 1), a2 + hstepA, voffA);
            PG8_WAIT_L(8); PG8_BAR; PG8_WAIT_L(0); PG8_MMA(0, 0, At, B0); PG8_BAR; PG8_SCHED;
            PG8_LDB(B1, 1, 1); PG8_STAGE(PG8_SB(1, 0), b3, voffB);
            PG8_BAR; PG8_WAIT_L(0); PG8_MMA(0, 1, At, B1); PG8_BAR;
            PG8_LDA(At, 1, 1); PG8_STAGE(PG8_SA(1, 0), a3, voffA);
            PG8_BAR; PG8_WAIT_L(0); PG8_MMA(1, 0, At, B0); PG8_BAR; PG8_SCHED;
            PG8_STAGE(PG8_SB(1, 1), b3 + hstepB, voffB);
            PG8_WAIT_V(6); PG8_BAR; PG8_MMA(1, 1, At, B1); PG8_BAR;
        }
        E(acc, cur, wr, wc, fr, fq); S.done(cur);
        if (!has_next) break;
#pragma unroll
        for (int a = 0; a < 2; ++a)
#pragma unroll
            for (int b = 0; b < 2; ++b)
#pragma unroll
                for (int m = 0; m < 4; ++m)
#pragma unroll
                    for (int n = 0; n < 2; ++n) acc[a][b][m][n] = (f32x4){0.f, 0.f, 0.f, 0.f};
        cur = nxt; cA = nA; cB = nB; ++ui;
    }
    PG8_WAIT_V(0);
    if (wr == 0) PG8_BAR;
    PG8_BAR;
#undef PG8_SA
#undef PG8_SB
#undef PG8_STAGE
#undef PG8_LDA
#undef PG8_LDB
#undef PG8_MMA
#undef PG8_WAIT_V
#undef PG8_WAIT_L
#undef PG8_BAR
#undef PG8_SCHED
}
}

typedef f32x4 AccT[2][2][4][2];

struct EpiSwiglu {
    static constexpr bool PERM = true;
    bf16_t* O;
    DEVI void operator()(const AccT& acc, const pg8::Unit& u, int wr, int wc, int fr, int fq) const {
        const int row0 = u.pm * 256 + wr * 64 + fr, col0 = u.pn * 128 + wc * 32 + 8 * fq;
#pragma unroll
        for (int ai = 0; ai < 2; ++ai)
#pragma unroll
            for (int m = 0; m < 4; ++m) {
                bf16_t* rowp = O + (size_t)(row0 + ai * 128 + m * 16) * DFF + col0;
                float h[8];
#pragma unroll
                for (int n = 0; n < 2; ++n)
#pragma unroll
                    for (int e = 0; e < 4; ++e) { const float a = acc[ai][0][m][n][e], gg = acc[ai][1][m][n][e]; h[n * 4 + e] = a * gg * fast_sigmoid(gg); }
                u32x4 w; w.x = cvt_pk_bf16(h[0], h[1]); w.y = cvt_pk_bf16(h[2], h[3]); w.z = cvt_pk_bf16(h[4], h[5]); w.w = cvt_pk_bf16(h[6], h[7]);
                *(u32x4*)rowp = w;
            }
    }
};
struct EpiResGate {
    static constexpr bool PERM = false;
    const float* resLat; const float* resCtx; float* out; const float* mod; int seg; float gs;
    DEVI void operator()(const AccT& acc, const pg8::Unit& u, int wr, int wc, int fr, int fq) const {
        const int row0 = u.pm * 256 + wr * 64 + fr, col0 = u.pn * 256 + wc * 32 + 4 * fq;
        const bool isctx = u.pm >= (MLAT / 256); const int b = isctx ? 8 : (u.pm >> 4);
        const float* gp = mod + (size_t)b * 9216 + seg * 1024 + col0;
        const float* rbase = (isctx ? resCtx + (size_t)(row0 - MLAT) * D : resLat + (size_t)row0 * D) + col0;
        float* obase = out + (size_t)row0 * D + col0;
        f32x4 cur[8], nxt[8];
#pragma unroll
        for (int q = 0; q < 8; ++q) cur[q] = *(const f32x4*)(rbase + (size_t)((q >> 2) * 128 + (q & 3) * 16) * D);
#pragma unroll
        for (int cgi = 0; cgi < 4; ++cgi) {
            const int bj = cgi >> 1, n = cgi & 1, co = bj * 128 + n * 16;
            if (cgi < 3) { const int co2 = ((cgi + 1) >> 1) * 128 + ((cgi + 1) & 1) * 16;
#pragma unroll
                for (int q = 0; q < 8; ++q) nxt[q] = *(const f32x4*)(rbase + (size_t)((q >> 2) * 128 + (q & 3) * 16) * D + co2); }
            const f32x4 gvv = *(const f32x4*)(gp + co) * gs;
#pragma unroll
            for (int q = 0; q < 8; ++q) *(f32x4*)(obase + (size_t)((q >> 2) * 128 + (q & 3) * 16) * D + co) = cur[q] * ALPHA + gvv * acc[q >> 2][bj][q & 3][n];
#pragma unroll
            for (int q = 0; q < 8; ++q) cur[q] = nxt[q];
        }
    }
};
struct EpiLnResGate {
    static constexpr bool PERM = false;
    float* V; const float* stats; const float* lng; const float* lnb; const float* mod; int seg; float gs;
    DEVI void operator()(const AccT& acc, const pg8::Unit& u, int wr, int wc, int fr, int fq) const {
        const int row0 = u.pm * 256 + wr * 64 + fr, col0 = u.pn * 256 + wc * 32 + 4 * fq;
        const int b = u.pm >> 4;
        const float* gp = mod + (size_t)b * 9216 + seg * 1024 + col0;
        float* vbase = V + (size_t)row0 * D + col0;
        f32x2 st[8];
        f32x4 cur[8], nxt[8];
#pragma unroll
        for (int q = 0; q < 8; ++q) { st[q] = *(const f32x2*)(stats + (size_t)(row0 + (q >> 2) * 128 + (q & 3) * 16) * 2); cur[q] = *(const f32x4*)(vbase + (size_t)((q >> 2) * 128 + (q & 3) * 16) * D); }
#pragma unroll
        for (int cgi = 0; cgi < 4; ++cgi) {
            const int bj = cgi >> 1, n = cgi & 1, co = bj * 128 + n * 16;
            if (cgi < 3) { const int co2 = ((cgi + 1) >> 1) * 128 + ((cgi + 1) & 1) * 16;
#pragma unroll
                for (int q = 0; q < 8; ++q) nxt[q] = *(const f32x4*)(vbase + (size_t)((q >> 2) * 128 + (q & 3) * 16) * D + co2); }
            const f32x4 gvv = *(const f32x4*)(gp + co) * gs, lg = *(const f32x4*)(lng + col0 + co) * ALPHA, lb = *(const f32x4*)(lnb + col0 + co) * ALPHA;
#pragma unroll
            for (int q = 0; q < 8; ++q) *(f32x4*)(vbase + (size_t)((q >> 2) * 128 + (q & 3) * 16) * D + co) = ((cur[q] - st[q].x) * st[q].y) * lg + lb + gvv * acc[q >> 2][bj][q & 3][n];
#pragma unroll
            for (int q = 0; q < 8; ++q) cur[q] = nxt[q];
        }
    }
};
struct EpiQKVU {
    static constexpr bool PERM = true;
    bf16_t* qkv; bf16_t* Ur;
    DEVI void operator()(const AccT& acc, const pg8::Unit& u, int wr, int wc, int fr, int fq) const {
        const int row0 = u.pm * 256 + wr * 64 + fr;
#pragma unroll
        for (int ai = 0; ai < 2; ++ai)
#pragma unroll
            for (int m = 0; m < 4; ++m) {
                const int r = row0 + ai * 128 + m * 16;
#pragma unroll
                for (int bj = 0; bj < 2; ++bj) {
                    const f32x4 v0 = acc[ai][bj][m][0], v1 = acc[ai][bj][m][1];
                    u32x4 w; w.x = cvt_pk_bf16(v0[0], v0[1]); w.y = cvt_pk_bf16(v0[2], v0[3]); w.z = cvt_pk_bf16(v1[0], v1[1]); w.w = cvt_pk_bf16(v1[2], v1[3]);
                    if (u.pn < 6) { *(u32x4*)(qkv + (size_t)r * 1536 + u.pn * 256 + bj * 128 + wc * 32 + 8 * fq) = w; }
                    else {
                        const int ucol = (u.pn - 6) * 256 + bj * 128 + wc * 32 + 8 * fq, g = ucol >> 4, cp = ucol & 15;
                        int R, s;
                        if (r < MLAT) { const int b = r >> 12, t = r & 4095; R = b * 128 + (t >> 5); s = t & 31; }
                        else { const int rc = r - MLAT, b = rc >> 8, t = rc & 255; R = 1024 + b * 8 + (t >> 5); s = t & 31; }
                        *(u32x4*)(Ur + ((size_t)(g * UR_ROWS + R) * UR_LD + s * 16 + cp)) = w;
                    }
                }
            }
    }
};
struct EpiF32 {
    static constexpr bool PERM = false;
    float* C; int ldc;
    DEVI void operator()(const AccT& acc, const pg8::Unit& u, int wr, int wc, int fr, int fq) const {
        const int row0 = u.pm * 256 + wr * 64 + fr, col0 = wc * 32 + 4 * fq;
#pragma unroll
        for (int ai = 0; ai < 2; ++ai)
#pragma unroll
            for (int m = 0; m < 4; ++m) { float* rowp = C + (size_t)(row0 + ai * 128 + m * 16) * ldc + col0;
#pragma unroll
                for (int bj = 0; bj < 2; ++bj)
#pragma unroll
                    for (int n = 0; n < 2; ++n) *(f32x4*)(rowp + bj * 128 + n * 16) = acc[ai][bj][m][n]; }
    }
};
struct EpiS5Y {
    static constexpr bool PERM = true;
    bf16_t* Yg;
    DEVI void operator()(const AccT& acc, const pg8::Unit& u, int wr, int wc, int fr, int fq) const {
        const int g = u.pm / 5, pml = u.pm - g * 5, pnl = u.pn - g * 2;
        const int R0 = pml * 256 + wr * 64 + fr;
#pragma unroll
        for (int ai = 0; ai < 2; ++ai)
#pragma unroll
            for (int m = 0; m < 4; ++m) {
                const int R = R0 + ai * 128 + m * 16, b = R >> 7, k = R & 127;
#pragma unroll
                for (int bj = 0; bj < 2; ++bj) {
                    const int nl = pnl * 256 + bj * 128 + wc * 32 + 8 * fq, j = nl >> 4, cch = nl & 15;
                    float h[8];
#pragma unroll
                    for (int n = 0; n < 2; ++n)
#pragma unroll
                        for (int e = 0; e < 4; ++e) h[n * 4 + e] = gelu_tanh(acc[ai][bj][m][n][e]);
                    u32x4 w; w.x = cvt_pk_bf16(h[0], h[1]); w.y = cvt_pk_bf16(h[2], h[3]); w.z = cvt_pk_bf16(h[4], h[5]); w.w = cvt_pk_bf16(h[6], h[7]);
                    *(u32x4*)(Yg + (size_t)(b * 4096 + k * 32 + j) * 512 + g * 16 + cch) = w;
                }
            }
    }
};
struct EpiGlu {
    static constexpr bool PERM = true;
    const bf16_t* Yg; const float* bglu; bf16_t* Ycat;
    DEVI void operator()(const AccT& acc, const pg8::Unit& u, int wr, int wc, int fr, int fq) const {
        const int row0 = u.pm * 256 + wr * 64 + fr, cbase = u.pn * 256 + wc * 32 + 8 * fq;
        u32x4 gw[2][8];
#pragma unroll
        for (int bj = 0; bj < 2; ++bj)
#pragma unroll
            for (int q = 0; q < 8; ++q) gw[bj][q] = *(const u32x4*)(Yg + (size_t)(row0 + (q >> 2) * 128 + (q & 3) * 16) * 512 + cbase + bj * 128);
#pragma unroll
        for (int bj = 0; bj < 2; ++bj) {
            const int c0 = cbase + bj * 128;
            const f32x4 b0 = *(const f32x4*)(bglu + c0), b1 = *(const f32x4*)(bglu + c0 + 4);
#pragma unroll
            for (int q = 0; q < 8; ++q) {
                const int ai = q >> 2, m = q & 3, r = row0 + ai * 128 + m * 16;
                const u32x4 g4 = gw[bj][q];
                const f32x4 v0 = acc[ai][bj][m][0] + b0, v1 = acc[ai][bj][m][1] + b1;
                float h[8];
                h[0] = __uint_as_float(g4.x << 16) * fast_sigmoid(v0[0]); h[1] = __uint_as_float(g4.x & 0xffff0000u) * fast_sigmoid(v0[1]);
                h[2] = __uint_as_float(g4.y << 16) * fast_sigmoid(v0[2]); h[3] = __uint_as_float(g4.y & 0xffff0000u) * fast_sigmoid(v0[3]);
                h[4] = __uint_as_float(g4.z << 16) * fast_sigmoid(v1[0]); h[5] = __uint_as_float(g4.z & 0xffff0000u) * fast_sigmoid(v1[1]);
                h[6] = __uint_as_float(g4.w << 16) * fast_sigmoid(v1[2]); h[7] = __uint_as_float(g4.w & 0xffff0000u) * fast_sigmoid(v1[3]);
                u32x4 w; w.x = cvt_pk_bf16(h[0], h[1]); w.y = cvt_pk_bf16(h[2], h[3]); w.z = cvt_pk_bf16(h[4], h[5]); w.w = cvt_pk_bf16(h[6], h[7]);
                *(u32x4*)(Ycat + (size_t)r * 1024 + 512 + c0) = w;
            }
        }
    }
};

DEVI void mod_gemv(const Params& p, float* lf) {
    const int tid = threadIdx.x;
    float* sc = lf; float* red = lf + 9 * 1024;
    for (int i = tid; i < 9 * 1024; i += 512) { const int r = i >> 10, k = i & 1023; const float v = r < 8 ? p.c[r * 1024 + k] : p.c_ctx[k]; sc[i] = v / (1.0f + __expf(-v)); }
    __syncthreads();
    for (int item = blockIdx.x; item < 288; item += gridDim.x) {
        const int cl = tid & 31, col = item * 32 + cl, kp = tid >> 5;
        float a0 = 0, a1 = 0, a2 = 0, a3 = 0, a4 = 0, a5 = 0, a6 = 0, a7 = 0, a8 = 0;
        float wv[64];
#pragma unroll
        for (int kk = 0; kk < 64; ++kk) wv[kk] = p.w_ada[(size_t)(kp * 64 + kk) * 9216 + col];
#pragma unroll
        for (int kk = 0; kk < 64; ++kk) { const int k = kp * 64 + kk; const float w = wv[kk];
            a0 += sc[k] * w; a1 += sc[1024 + k] * w; a2 += sc[2048 + k] * w; a3 += sc[3072 + k] * w; a4 += sc[4096 + k] * w;
            a5 += sc[5120 + k] * w; a6 += sc[6144 + k] * w; a7 += sc[7168 + k] * w; a8 += sc[8192 + k] * w; }
        float* rp = red + kp * 288 + cl;
        rp[0] = a0; rp[32] = a1; rp[64] = a2; rp[96] = a3; rp[128] = a4; rp[160] = a5; rp[192] = a6; rp[224] = a7; rp[256] = a8;
        __syncthreads();
        if (tid < 288) { const int r = tid >> 5, cc = tid & 31; float s = 0.f;
#pragma unroll
            for (int q = 0; q < 16; ++q) s += red[q * 288 + r * 32 + cc];
            p.mod[r * 9216 + item * 32 + cc] = s + p.b_ada[item * 32 + cc]; }
        __syncthreads();
    }
}
DEVI void transpose_quad(const float* src, bf16_t* dst, int K, int N, bool swz, float* tile  , int t0) {
    const int tid = threadIdx.x, tn = N / 64, tk = K / 64, ntile = tn * tk;
    {
        f32x4 v[4][2];
#pragma unroll
        for (int q = 0; q < 4; ++q) { const int t = t0 + q; if (t < ntile) {
            const int n0 = (t % tn) * 64, k0 = (t / tn) * 64;
            int sc0 = n0; if (swz) { const int pn = n0 >> 8, i = n0 & 255; sc0 = (i < 128) ? pn * 128 + i : DFF + pn * 128 + (i - 128); }
#pragma unroll
            for (int h = 0; h < 2; ++h) { const int kk = (tid >> 4) + h * 32, c4 = (tid & 15) * 4; v[q][h] = *(const f32x4*)(src + (size_t)(k0 + kk) * N + sc0 + c4); } } }
        __syncthreads();
#pragma unroll
        for (int q = 0; q < 4; ++q) { if (t0 + q < ntile) {
#pragma unroll
            for (int h = 0; h < 2; ++h) { const int kk = (tid >> 4) + h * 32, c4 = (tid & 15) * 4; float* tp = tile + q * 4160 + kk * 65 + c4;
                tp[0] = v[q][h][0]; tp[1] = v[q][h][1]; tp[2] = v[q][h][2]; tp[3] = v[q][h][3]; } } }
        __syncthreads();
#pragma unroll
        for (int q = 0; q < 4; ++q) { const int t = t0 + q; if (t < ntile) {
            const int n0 = (t % tn) * 64, k0 = (t / tn) * 64;
            const int n = tid >> 3, k8 = (tid & 7) * 8;
            float h[8];
#pragma unroll
            for (int e = 0; e < 8; ++e) h[e] = tile[q * 4160 + (k8 + e) * 65 + n];
            u32x4 w; w.x = cvt_pk_bf16(h[0], h[1]); w.y = cvt_pk_bf16(h[2], h[3]); w.z = cvt_pk_bf16(h[4], h[5]); w.w = cvt_pk_bf16(h[6], h[7]);
            *(u32x4*)(dst + (size_t)(n0 + n) * K + k0 + k8) = w; } }
    }
}
DEVI void transpose_all(const Params& p, float* tile) {
    for (int qi = blockIdx.x; qi < 1264; qi += gridDim.x) {
        const float* src; bf16_t* dst; int K, N, base; bool swz = false;
        if (qi < 352)       { src = p.w_up1; dst = p.wup1t; K = D;   N = 2 * DFF; base = 0;    swz = true; }
        else if (qi < 528)  { src = p.w_dn1; dst = p.wdn1t; K = DFF; N = D;       base = 352; }
        else if (qi < 656)  { src = p.w_in;  dst = p.wint;  K = D;   N = 2048;    base = 528; }
        else if (qi < 672)  { src = p.w_glu; dst = p.wglut; K = 512; N = 512;     base = 656; }
        else if (qi < 736)  { src = p.w_out; dst = p.woutt; K = D;   N = D;       base = 672; }
        else if (qi < 1088) { src = p.w_up2; dst = p.wup2t; K = D;   N = 2 * DFF; base = 736;  swz = true; }
        else                { src = p.w_dn2; dst = p.wdn2t; K = DFF; N = D;       base = 1088; }
        transpose_quad(src, dst, K, N, swz, tile, (qi - base) * 4);
    }
}
DEVI void s5_tables(const Params& p, float* lf) {
    const int tid = threadIdx.x;
    f32x2* pw = (f32x2*)lf;
    f32x2* Cc = pw + 33 * 64;
    f32x2* Bb = Cc + 16 * 64;
    f32x2* cf = Bb + 64 * 16;
    for (int item = blockIdx.x; item < 256; item += gridDim.x) {
        const int dir = item >> 7, g = (item >> 2) & 31, qt = item & 3;
        __syncthreads();
        if (tid < 64) {
            const int pi = (dir * 32 + g) * 64 + tid;
            const float ar = p.a_re[pi], ai = p.a_im[pi], dt = expf(p.log_dt[dir * 32 + g]);
            const float xr = ar * dt, yi = ai * dt; float sn, cs, sh, ch; sincosf(yi, &sn, &cs); sincosf(0.5f * yi, &sh, &ch);
            const float em1 = expm1f(xr), mg = em1 + 1.0f, abr = mg * cs, abi = mg * sn;
            float wr_ = 1.0f, wi_ = 0.0f; pw[tid] = (f32x2){1.0f, 0.0f};
            for (int e = 1; e <= 32; ++e) { const float nr_ = wr_ * abr - wi_ * abi, ni_ = wr_ * abi + wi_ * abr; wr_ = nr_; wi_ = ni_; pw[e * 64 + tid] = (f32x2){wr_, wi_}; }
            const float nr = em1 * cs - 2.0f * sh * sh, ni = mg * sn;
            const float den = 1.0f / (ar * ar + ai * ai);
            cf[tid] = (f32x2){(nr * ar + ni * ai) * den, (ni * ar - nr * ai) * den};
        }
        __syncthreads();
        for (int i = tid; i < 1024; i += 512) {
            { const int pp = i >> 4; const size_t gi = ((size_t)(dir * 32 + g) * 64) * 16 + i; const float br = p.b_re[gi], bi = p.b_im[gi]; const f32x2 f = cf[pp];
              Bb[i] = (f32x2){f.x * br - f.y * bi, f.x * bi + f.y * br}; }
            { const size_t gi = ((size_t)(dir * 32 + g) * 16) * 64 + i; Cc[i] = (f32x2){p.c_re[gi], p.c_im[gi]}; }
        }
        __syncthreads();
        {
            const int cc = tid & 255, c = cc >> 4, cq = cc & 15, tau0 = qt * 8 + (tid >> 8) * 4;
            float s0 = 0.f, s1 = 0.f, s2 = 0.f, s3 = 0.f;
            for (int pp = 0; pp < 64; ++pp) { const f32x2 bb = Bb[pp * 16 + cq], c2 = Cc[c * 64 + pp];
                const float mr = c2.x * bb.x - c2.y * bb.y, mi = c2.x * bb.y + c2.y * bb.x;
                const f32x2 w0 = pw[tau0 * 64 + pp], w1 = pw[(tau0 + 1) * 64 + pp], w2 = pw[(tau0 + 2) * 64 + pp], w3 = pw[(tau0 + 3) * 64 + pp];
                s0 += w0.x * mr - w0.y * mi; s1 += w1.x * mr - w1.y * mi; s2 += w2.x * mr - w2.y * mi; s3 += w3.x * mr - w3.y * mi; }
            float* kp = p.kt + ((size_t)((dir * 32 + g) * 32 + tau0)) * 256 + cc;
            kp[0] = s0; kp[256] = s1; kp[512] = s2; kp[768] = s3;
        }
        for (int idx = tid; idx < 32 * 512; idx += 512) {
            const int n = qt * 32 + (idx >> 9), k = idx & 511, pp = n >> 1, ri = n & 1, sI = k >> 4, cq = k & 15, e = dir == 0 ? 31 - sI : sI;
            const f32x2 w = pw[e * 64 + pp], bb = Bb[pp * 16 + cq];
            const float v = ri == 0 ? (w.x * bb.x - w.y * bb.y) : (w.x * bb.y + w.y * bb.x);
            p.wE[(size_t)(g * 256 + dir * 128 + n) * 512 + k] = (bf16_t)(cvt_pk_bf16(v, 0.f) & 0xffffu);
        }
        for (int idx = tid; idx < 128 * 128; idx += 512) {
            const int nrow = qt * 128 + (idx >> 7), kk = idx & 127, pp = kk >> 1, ri = kk & 1, j = nrow >> 4, c = nrow & 15, e = dir == 0 ? j + 1 : 32 - j;
            const f32x2 w = pw[e * 64 + pp], c2 = Cc[c * 64 + pp];
            const float v = ri == 0 ? (c2.x * w.x - c2.y * w.y) : -(c2.x * w.y + c2.y * w.x);
            p.wY[(size_t)(g * 512 + nrow) * UR_LD + 512 + dir * 128 + kk] = (bf16_t)(cvt_pk_bf16(v, 0.f) & 0xffffu);
        }
    }
}
DEVI void toeplitz_expand(const Params& p) {
    const size_t total = (size_t)32 * 512 * 64, stride = (size_t)gridDim.x * 512;
    for (size_t i0 = (size_t)blockIdx.x * 512 + threadIdx.x; i0 < total; i0 += stride * 4) {
        f32x4 f0[4], f1[4], b0[4], b1[4]; float dv[4];
#pragma unroll
        for (int q = 0; q < 4; ++q) { const size_t i = i0 + q * stride;
            f0[q] = (f32x4){0.f, 0.f, 0.f, 0.f}; f1[q] = f0[q]; b0[q] = f0[q]; b1[q] = f0[q]; dv[q] = 0.f;
            if (i < total) { const int ko = (int)(i & 63), n = (int)((i >> 6) & 511), g = (int)(i >> 15);
                const int j = n >> 4, c = n & 15, sI = ko >> 1, c0 = (ko & 1) * 8;
                if (sI <= j) { const float* kp = p.kt + ((size_t)((0 * 32 + g) * 32 + (j - sI))) * 256 + c * 16 + c0; f0[q] = *(const f32x4*)kp; f1[q] = *(const f32x4*)(kp + 4); }
                if (sI >= j) { const float* kp = p.kt + ((size_t)((1 * 32 + g) * 32 + (sI - j))) * 256 + c * 16 + c0; b0[q] = *(const f32x4*)kp; b1[q] = *(const f32x4*)(kp + 4); }
                if (sI == j) dv[q] = p.s5d[g * 16 + c]; } }
#pragma unroll
        for (int q = 0; q < 4; ++q) { const size_t i = i0 + q * stride;
            if (i < total) { const int ko = (int)(i & 63), n = (int)((i >> 6) & 511), g = (int)(i >> 15);
                const int c = n & 15, sI = ko >> 1, c0 = (ko & 1) * 8;
                float h[8];
#pragma unroll
                for (int e = 0; e < 4; ++e) { h[e] = f0[q][e] + b0[q][e]; h[4 + e] = f1[q][e] + b1[q][e]; }
#pragma unroll
                for (int e = 0; e < 8; ++e) if (c0 + e == c) h[e] += dv[q];
                u32x4 w; w.x = cvt_pk_bf16(h[0], h[1]); w.y = cvt_pk_bf16(h[2], h[3]); w.z = cvt_pk_bf16(h[4], h[5]); w.w = cvt_pk_bf16(h[6], h[7]);
                *(u32x4*)(p.wY + (size_t)(g * 512 + n) * UR_LD + sI * 16 + c0) = w; } }
    }
}
DEVI void modulate_in(const Params& p) {
    const size_t total = (size_t)MALL * 256, stride = (size_t)gridDim.x * 512;
    for (size_t i0 = (size_t)blockIdx.x * 512 + threadIdx.x; i0 < total; i0 += stride * 8) {
        f32x4 v[8], sh[8], sc[8];
#pragma unroll
        for (int q = 0; q < 8; ++q) { const size_t i = i0 + q * stride; if (i < total) { const int r = (int)(i >> 8), c4 = (int)(i & 255) * 4;
            const float* src = r < MLAT ? p.x + (size_t)r * D : p.ctx + (size_t)(r - MLAT) * D; v[q] = *(const f32x4*)(src + c4);
            const int b = r < MLAT ? (r >> 12) : 8;
            sh[q] = *(const f32x4*)(p.mod + b * 9216 + c4); sc[q] = *(const f32x4*)(p.mod + b * 9216 + 1024 + c4); } }
#pragma unroll
        for (int q = 0; q < 8; ++q) { const size_t i = i0 + q * stride; if (i < total) { const int r = (int)(i >> 8), c4 = (int)(i & 255) * 4;
            const f32x4 a = v[q] * (sc[q] + 1.0f) + sh[q];
            u32x2 w; w.x = cvt_pk_bf16(a[0], a[1]); w.y = cvt_pk_bf16(a[2], a[3]);
            *(u32x2*)(p.A + (size_t)r * D + c4) = w; } }
    }
}
DEVI void ln_phase(const Params& p, int rbeg, int rend, int bidx, int nblk, int lnidx, float* xout, float* stats, bool writeA, int seg) {
    const int tid = threadIdx.x, wid = tid >> 6, lane = tid & 63;
    const float* gp = p.ln_g + lnidx * 1024; const float* bp = p.ln_b + lnidx * 1024;
    f32x4 gv[4], bv[4], shv[4], scv[4];
#pragma unroll
    for (int i = 0; i < 4; ++i) { gv[i] = *(const f32x4*)(gp + i * 256 + lane * 4); bv[i] = *(const f32x4*)(bp + i * 256 + lane * 4); shv[i] = gv[i]; scv[i] = gv[i]; }
    int bcur = -1;
    const int chunk = (rend - rbeg + nblk - 1) / nblk, cbeg = rbeg + bidx * chunk, cend = min(cbeg + chunk, rend);
    for (int row0 = cbeg + wid; row0 < cend; row0 += 32) {
        f32x4 v[4][4];
#pragma unroll
        for (int j = 0; j < 4; ++j) { const int row = row0 + j * 8; if (row < cend) { const float* vp = p.V + (size_t)row * D;
#pragma unroll
            for (int i = 0; i < 4; ++i) v[j][i] = *(const f32x4*)(vp + i * 256 + lane * 4); } }
#pragma unroll
        for (int j = 0; j < 4; ++j) { const int row = row0 + j * 8; if (row < cend) {
            float s = 0.f;
#pragma unroll
            for (int i = 0; i < 4; ++i) s += (v[j][i][0] + v[j][i][1]) + (v[j][i][2] + v[j][i][3]);
#pragma unroll
            for (int o = 32; o >= 1; o >>= 1) s += __shfl_xor(s, o);
            const float mean = s * (1.0f / 1024.0f);
            float q = 0.f;
#pragma unroll
            for (int i = 0; i < 4; ++i) { const f32x4 d = v[j][i] - mean; q += (d[0] * d[0] + d[1] * d[1]) + (d[2] * d[2] + d[3] * d[3]); }
#pragma unroll
            for (int o = 32; o >= 1; o >>= 1) q += __shfl_xor(q, o);
            const float rstd = rsqrtf(q * (1.0f / 1024.0f) + 1e-6f);
            const int b = row < MLAT ? (row >> 12) : 8;
            if (writeA && b != bcur) { bcur = b; const float* mp = p.mod + b * 9216 + seg * 1024;
#pragma unroll
                for (int i = 0; i < 4; ++i) { shv[i] = *(const f32x4*)(mp + i * 256 + lane * 4); scv[i] = *(const f32x4*)(mp + 1024 + i * 256 + lane * 4) + 1.0f; } }
            if (stats && lane == 0) *(f32x2*)(stats + (size_t)row * 2) = (f32x2){mean, rstd};
#pragma unroll
            for (int i = 0; i < 4; ++i) {
                const int col = i * 256 + lane * 4;
                const f32x4 xn = (v[j][i] - mean) * rstd * gv[i] + bv[i];
                if (xout) *(f32x4*)(xout + (size_t)row * D + col) = xn;
                if (writeA) { const f32x4 a = xn * scv[i] + shv[i];
                    u32x2 w; w.x = cvt_pk_bf16(a[0], a[1]); w.y = cvt_pk_bf16(a[2], a[3]); *(u32x2*)(p.A + (size_t)row * D + col) = w; }
            } } }
    }
}

DEVI float xmax16(float x) { auto rr = __builtin_amdgcn_permlane16_swap(__float_as_uint(x), __float_as_uint(x), false, false); return fmaxf(__uint_as_float(rr[0]), __uint_as_float(rr[1])); }
DEVI float xmax32(float x) { auto rr = __builtin_amdgcn_permlane32_swap(__float_as_uint(x), __float_as_uint(x), false, false); return fmaxf(__uint_as_float(rr[0]), __uint_as_float(rr[1])); }
DEVI float xsum16(float x) { auto rr = __builtin_amdgcn_permlane16_swap(__float_as_uint(x), __float_as_uint(x), false, false); return __uint_as_float(rr[0]) + __uint_as_float(rr[1]); }
DEVI float xsum32(float x) { auto rr = __builtin_amdgcn_permlane32_swap(__float_as_uint(x), __float_as_uint(x), false, false); return __uint_as_float(rr[0]) + __uint_as_float(rr[1]); }
constexpr int NA_PITCH = 288, NA_TILE = 64 * NA_PITCH, NA_BUF = 2 * NA_TILE, NA_RPB_OFF = 2 * NA_BUF;
template <bool WIN>
DEVI void na_tile(const LAS unsigned char* kb, const LAS unsigned char* vb, const LAS float* bl, const bf16x8 qf0, const bf16x8 qf1,
                  const int hh, const int fr, const int fq, const int trq, const int trp, const int w, const int cs, const int kc0,
                  float& m_run, float& l_run, f32x4 (&o)[4]) {
    const float SCL = 0.125f * LOG2E;
    constexpr int NJ = WIN ? 2 : 4;
    const int k0 = WIN ? kc0 : 0;
    f32x4 s[NJ];
#pragma unroll
    for (int j = 0; j < NJ; ++j) {
        const LAS unsigned char* ka = kb + (k0 + 16 * j + fr) * NA_PITCH + (hh * 64 + 8 * fq) * 2;
        const bf16x8 k0v = *(const LAS bf16x8*)ka, k1v = *(const LAS bf16x8*)(ka + 64);
        f32x4 a = (f32x4){0.f, 0.f, 0.f, 0.f};
        a = __builtin_amdgcn_mfma_f32_16x16x32_bf16(k0v, qf0, a, 0, 0, 0);
        a = __builtin_amdgcn_mfma_f32_16x16x32_bf16(k1v, qf1, a, 0, 0, 0);
        if (WIN) {
#pragma unroll
            for (int e = 0; e < 4; ++e) { const int kc = k0 + 16 * j + 4 * fq + e; const bool valid = (unsigned)(kc - cs) < 16u;
                const float t = a[e] * SCL + bl[valid ? kc : w]; a[e] = valid ? t : -1e30f; }
        } else a = a * SCL;
        s[j] = a;
    }
    float mx = -1e30f;
#pragma unroll
    for (int j = 0; j < NJ; ++j) mx = fmaxf(mx, fmaxf(fmaxf(s[j][0], s[j][1]), fmaxf(s[j][2], s[j][3])));
    mx = xmax16(mx); mx = xmax32(mx);
    const float mn = fmaxf(m_run, mx), al = __builtin_amdgcn_exp2f(m_run - mn); m_run = mn;
    float ps = 0.f;
#pragma unroll
    for (int j = 0; j < NJ; ++j)
#pragma unroll
        for (int e = 0; e < 4; ++e) { const float pe = __builtin_amdgcn_exp2f(s[j][e] - mn); s[j][e] = pe; ps += pe; }
    l_run = l_run * al + ps;
#pragma unroll
    for (int c = 0; c < 4; ++c) o[c] = o[c] * al;
#pragma unroll
    for (int kk = 0; kk < NJ / 2; ++kk) {
        u32x4 pw; pw.x = cvt_pk_bf16(s[2 * kk][0], s[2 * kk][1]); pw.y = cvt_pk_bf16(s[2 * kk][2], s[2 * kk][3]);
        pw.z = cvt_pk_bf16(s[2 * kk + 1][0], s[2 * kk + 1][1]); pw.w = cvt_pk_bf16(s[2 * kk + 1][2], s[2 * kk + 1][3]);
        const bf16x8 pf = __builtin_bit_cast(bf16x8, pw);
#pragma unroll
        for (int c = 0; c < 4; ++c) {
            const LAS unsigned char* va = vb + (k0 + 32 * kk + 4 * fq + trq) * NA_PITCH + (hh * 64 + 16 * c + 4 * trp) * 2;
            const s16x4 v0 = __builtin_bit_cast(s16x4, __builtin_amdgcn_ds_read_tr16_b64_v4i16((LAS s16x4*)va));
            const s16x4 v1 = __builtin_bit_cast(s16x4, __builtin_amdgcn_ds_read_tr16_b64_v4i16((LAS s16x4*)(va + 16 * NA_PITCH)));
            const bf16x8 vf = (bf16x8){v0[0], v0[1], v0[2], v0[3], v1[0], v1[1], v1[2], v1[3]};
            o[c] = __builtin_amdgcn_mfma_f32_16x16x32_bf16(vf, pf, o[c], 0, 0, 0);
        }
    }
}
DEVI void na_phase(const Params& p, LAS unsigned char* lds) {
    const int tid = threadIdx.x, wid = __builtin_amdgcn_readfirstlane(tid >> 6), lane = tid & 63, fr = lane & 15, fq = lane >> 4;
    const int hh = wid >> 2, qb = wid & 3;
    const int kc0 = qb == 0 ? 0 : (qb == 3 ? 32 : 16 * qb - 8);
    LAS float* rpbL = (LAS float*)(lds + NA_RPB_OFF);
    const int skey = tid >> 3, sch = (tid & 7) * 2;
    const int trq = (lane & 15) >> 2, trp = lane & 3;
    const int w = qb * 16 + fr, cs = min(max(w - 8, 0), 48);
    for (int it = blockIdx.x; it < 2048; it += gridDim.x) {
        int r, hp, b;
        if (gridDim.x == 256) { const int c = it & 255, xcd = c & 7; b = it >> 8; hp = xcd & 3; r = (xcd >> 2) * 32 + (c >> 3); }
        else { r = it & 63; hp = (it >> 6) & 3; b = it >> 8; }
        const int r0 = min(max(r - 4, 0), 56);
        __syncthreads();
        for (int i = tid; i < 930; i += 512) rpbL[i] = p.rpb[hp * 930 + i] * LOG2E;
        const bf16_t* qrow = p.qkv + (size_t)(b * 4096 + r * 64 + qb * 16 + fr) * 1536 + (hp * 2 + hh) * 64 + fq * 8;
        const bf16x8 qf0 = *(const bf16x8*)qrow, qf1 = *(const bf16x8*)(qrow + 32);
        u32x4 ka0, ka1, va0, va1, kb0, kb1, vb0, vb1;
#define NA_LOAD(i_, K0, K1, V0, V1) do { const int tok_ = (i_) < 8 ? b * 4096 + (r0 + (i_)) * 64 + skey : MLAT + b * 256 + ((i_) - 8) * 64 + skey; \
        const bf16_t* kp_ = p.qkv + (size_t)tok_ * 1536 + 512 + hp * 128 + sch * 8; \
        K0 = *(const u32x4*)kp_; K1 = *(const u32x4*)(kp_ + 8); V0 = *(const u32x4*)(kp_ + 512); V1 = *(const u32x4*)(kp_ + 520); } while (0)
#define NA_STORE(buf_, K0, K1, V0, V1) do { LAS unsigned char* d_ = lds + (buf_) * NA_BUF + skey * NA_PITCH + sch * 16; \
        *(LAS u32x4*)d_ = K0; *(LAS u32x4*)(d_ + 16) = K1; *(LAS u32x4*)(d_ + NA_TILE) = V0; *(LAS u32x4*)(d_ + NA_TILE + 16) = V1; } while (0)
        NA_LOAD(0, ka0, ka1, va0, va1); NA_LOAD(1, kb0, kb1, vb0, vb1);
        NA_STORE(0, ka0, ka1, va0, va1);
        __syncthreads();
        float m_run = -1e30f, l_run = 0.f;
        f32x4 o[4];
#pragma unroll
        for (int c = 0; c < 4; ++c) o[c] = (f32x4){0.f, 0.f, 0.f, 0.f};
        for (int i = 0; i < 12; i += 2) {
            if (i + 2 < 12) NA_LOAD(i + 2, ka0, ka1, va0, va1);
            if (i < 8) na_tile<true>(lds, lds + NA_TILE, rpbL + hh * 465 + (r0 + i - r + 7) * 31 - w + 15, qf0, qf1, hh, fr, fq, trq, trp, w, cs, kc0, m_run, l_run, o);
            else na_tile<false>(lds, lds + NA_TILE, rpbL, qf0, qf1, hh, fr, fq, trq, trp, w, cs, kc0, m_run, l_run, o);
            NA_STORE(1, kb0, kb1, vb0, vb1);
            __syncthreads();
            if (i + 3 < 12) NA_LOAD(i + 3, kb0, kb1, vb0, vb1);
            if (i < 8) na_tile<true>(lds + NA_BUF, lds + NA_BUF + NA_TILE, rpbL + hh * 465 + (r0 + i + 1 - r + 7) * 31 - w + 15, qf0, qf1, hh, fr, fq, trq, trp, w, cs, kc0, m_run, l_run, o);
            else na_tile<false>(lds + NA_BUF, lds + NA_BUF + NA_TILE, rpbL, qf0, qf1, hh, fr, fq, trq, trp, w, cs, kc0, m_run, l_run, o);
            if (i + 2 < 12) NA_STORE(0, ka0, ka1, va0, va1);
            __syncthreads();
        }
#undef NA_LOAD
#undef NA_STORE
        l_run = xsum16(l_run); l_run = xsum32(l_run);
        const float inv = 1.0f / l_run;
        bf16_t* op = p.A + (size_t)(b * 4096 + r * 64 + qb * 16 + fr) * 1024 + (hp * 2 + hh) * 64 + 4 * fq;
#pragma unroll
        for (int c = 0; c < 4; ++c) { u32x2 w2; w2.x = cvt_pk_bf16(o[c][0] * inv, o[c][1] * inv); w2.y = cvt_pk_bf16(o[c][2] * inv, o[c][3] * inv); *(u32x2*)(op + 16 * c) = w2; }
    }
}

DEVI void s5_scan(const Params& p) {
    const int tid = threadIdx.x, wid = tid >> 6, lane = tid & 63;
    for (int w = wid * gridDim.x + blockIdx.x; w < 512; w += 8 * gridDim.x) {
        const int b = w >> 6, dir = (w >> 5) & 1, g = w & 31, pp = lane;
        const int pi = (dir * 32 + g) * 64 + pp;
        const float dt = expf(p.log_dt[dir * 32 + g]), xr = p.a_re[pi] * dt * 32.0f, yi = p.a_im[pi] * dt * 32.0f;
        float sn, cs; sincosf(yi, &sn, &cs); const float mg = expf(xr), ar = mg * cs, ai = mg * sn;
        const float* Eb = p.E + (size_t)g * UR_ROWS * 256 + dir * 128 + pp * 2;
        bf16_t* Ub = p.Ur + (size_t)g * UR_ROWS * UR_LD + 512 + dir * 128 + pp * 2;
        float hr = 0.f, hi = 0.f;
        for (int q = 0; q < 8; ++q) { const int kc = dir == 0 ? q : 7 - q; const f32x2 e = *(const f32x2*)(Eb + (size_t)(1024 + b * 8 + kc) * 256);
            const float nr = ar * hr - ai * hi + e.x, ni = ar * hi + ai * hr + e.y; hr = nr; hi = ni; }
        for (int q0 = 0; q0 < 128; q0 += 8) {
            f32x2 ev[8];
#pragma unroll
            for (int u = 0; u < 8; ++u) { const int k = dir == 0 ? q0 + u : 127 - (q0 + u); ev[u] = *(const f32x2*)(Eb + (size_t)(b * 128 + k) * 256); }
#pragma unroll
            for (int u = 0; u < 8; ++u) { const int k = dir == 0 ? q0 + u : 127 - (q0 + u);
                *(unsigned*)(Ub + (size_t)(b * 128 + k) * UR_LD) = cvt_pk_bf16(hr, hi);
                const float nr = ar * hr - ai * hi + ev[u].x, ni = ar * hi + ai * hr + ev[u].y; hr = nr; hi = ni; }
        }
    }
}


#define XB_TMO      128
#define XB_XCNT(j)  (256  + 64 * (j))
#define XB_XSUB(j)  (1280 + 64 * (j))
#define XB_XGEN(j)  (2304 + 64 * (j))
#define XB_TOP      3328
#define XB_TOPGEN   3392
#define XCD_BAR_WORDS 3456
#define XB_SPIN_CAP (1u << 22)
DEVI unsigned xb_ld(unsigned* p)              { return __hip_atomic_load(p, __ATOMIC_RELAXED, __HIP_MEMORY_SCOPE_AGENT); }
DEVI unsigned xb_add(unsigned* p, unsigned v) { return __hip_atomic_fetch_add(p, v, __ATOMIC_RELAXED, __HIP_MEMORY_SCOPE_AGENT); }
DEVI unsigned xb_xcc_id() { return (unsigned)__builtin_amdgcn_s_getreg((3 << 11) | 20) & 0xFu; }
#define XB_SPIN(cond, bar) do { unsigned _sp = 0; while (cond) { __builtin_amdgcn_s_sleep(1); \
    if ((++_sp & 255u) == 0u) { if (xb_ld(&(bar)[XB_TMO])) break; if (_sp > XB_SPIN_CAP) { atomicAdd(&(bar)[XB_TMO], 1u); break; } } } } while (0)
struct XcdBarrier { unsigned* bar; unsigned x; volatile LAS unsigned* st; };
DEVI XcdBarrier xcd_barrier_post(unsigned* bar, volatile LAS unsigned* st) {
    XcdBarrier b; b.bar = bar; b.x = xb_xcc_id(); b.st = st;
    if (threadIdx.x == 0) (void)xb_add(&bar[XB_XCNT(b.x)], 1u);
    return b;
}
DEVI void xcd_barrier_complete(unsigned* bar, unsigned x, unsigned& nloc, unsigned& nx) {
    const unsigned G = gridDim.x * gridDim.y * gridDim.z;
    unsigned sum, cnt, mine, sp = 0u;
    for (;;) {
        sum = 0u; cnt = 0u; mine = 0u;
#pragma unroll
        for (unsigned j = 0; j < 16; ++j) { const unsigned c = xb_ld(&bar[XB_XCNT(j)]); sum += c; cnt += (c > 0u) ? 1u : 0u; mine = (j == x) ? c : mine; }
        if (sum == G) break;
        __builtin_amdgcn_s_sleep(1);
        if ((++sp & 255u) == 0u) { if (xb_ld(&bar[XB_TMO])) break; if (sp > XB_SPIN_CAP) { atomicAdd(&bar[XB_TMO], 1u); break; } }
    }
    nloc = mine > 0u ? mine : 1u; nx = cnt > 0u ? cnt : 1u;
}
DEVI void xcd_barrier(const XcdBarrier& b) {
    asm volatile("s_waitcnt vmcnt(0)" ::: "memory");
    __syncthreads();
    if (threadIdx.x == 0) {
        unsigned* bar = b.bar;
        __builtin_amdgcn_s_waitcnt(0);
        unsigned nloc = b.st[0], nx = b.st[1];
        if (nloc == 0u) { xcd_barrier_complete(bar, b.x, nloc, nx); b.st[0] = nloc; b.st[1] = nx; }
        const unsigned old = xb_add(&bar[XB_XSUB(b.x)], 1u);
        const unsigned gen = old / nloc;
        if (old + 1u == (gen + 1u) * nloc) {
            __builtin_amdgcn_fence(__ATOMIC_RELEASE, "agent");
            asm volatile("s_waitcnt vmcnt(0)" ::: "memory");
            const unsigned og = xb_add(&bar[XB_TOP], 1u);
            const unsigned tg = og / nx;
            if (og + 1u == (tg + 1u) * nx) xb_add(&bar[XB_TOPGEN], 1u);
            else XB_SPIN(xb_ld(&bar[XB_TOPGEN]) == tg, bar);
            __builtin_amdgcn_fence(__ATOMIC_ACQUIRE, "agent");
            xb_add(&bar[XB_XGEN(b.x)], 1u);
            asm volatile("s_waitcnt vmcnt(0)" ::: "memory");
        } else {
            XB_SPIN(xb_ld(&bar[XB_XGEN(b.x)]) == gen, bar);
            __builtin_amdgcn_fence(__ATOMIC_ACQUIRE, "agent");
            asm volatile("s_waitcnt vmcnt(0)" ::: "memory");
        }
    }
    __syncthreads();
}

__global__ void __launch_bounds__(512, 2) mega(Params p) {
    extern __shared__ __attribute__((aligned(16))) unsigned char smem[];
    cg::grid_group grid = cg::this_grid();
    LAS unsigned char* lds = (LAS unsigned char*)smem;
    float* lf = (float*)smem;
    const int G = gridDim.x, cid = blockIdx.x;
    const int lo = p.ph_lo, hi = p.ph_hi;
    volatile LAS unsigned* xst = (volatile LAS unsigned*)(lds + LDS_MAIN);
    if (threadIdx.x < 4) xst[threadIdx.x] = 0u;
    __syncthreads();
    XcdBarrier xb; xb.bar = p.bar; xb.x = 0; xb.st = xst;
    if (hi - lo > 1) xb = xcd_barrier_post(p.bar, xst);
    if (lo < 0) grid.sync();
#define IN(k) (PH_ON(k) && lo <= (k) && (k) < hi)
#define SEAM(k) do { if (lo <= (k) && (k) + 1 < hi) { for (int sr_ = 0; sr_ < SYNC_REP; ++sr_) { xcd_barrier(xb); } } } while (0)
        if (IN(0)) for (int rep_ = 0; rep_ < REP0; ++rep_) {
            mod_gemv(p, lf);
            s5_tables(p, lf);
            transpose_all(p, lf);
        }
        SEAM(0);
        if (IN(1)) for (int rep_ = 0; rep_ < REP1; ++rep_) { modulate_in(p); toeplitz_expand(p); }
        SEAM(1);
        if (IN(2)) for (int rep_ = 0; rep_ < REP2; ++rep_) { pg8::Gemm g{p.A, p.wup1t, D, D, D}; pg8::StaticOrder S; S.init(MALL, 2 * DFF, G, cid); EpiSwiglu E{p.hid}; pg8::gemm_phase(lds, g, S, E); }
        SEAM(2);
        if (IN(3)) for (int rep_ = 0; rep_ < REP3; ++rep_) { pg8::Gemm g{p.hid, p.wdn1t, DFF, DFF, DFF}; pg8::StaticOrder S; S.init(MLAT, D, G, cid); EpiResGate E{p.x, p.ctx, p.V, p.mod, 2, 0.5f}; pg8::gemm_phase(lds, g, S, E); }
        SEAM(3);
        if (IN(4)) {
            const int Gc = G >= 64 ? 32 : 0;
            if (cid < Gc || Gc == 0) { pg8::Gemm g{p.hid, p.wdn1t, DFF, DFF, DFF}; pg8::GroupOrder S{1, 8, 4, 0, 0, Gc ? Gc : G, cid, MLAT / 256}; EpiResGate E{p.x, p.ctx, p.V, p.mod, 2, 0.5f}; pg8::gemm_phase(lds, g, S, E); }
            if (cid >= Gc) for (int rep_ = 0; rep_ < REP4; ++rep_) ln_phase(p, 0, MLAT, cid - Gc, G - Gc, 0, nullptr, p.stats, true, 3);
        }
        SEAM(4);
        if (IN(5)) ln_phase(p, MLAT, MALL, cid, G, 0, nullptr, nullptr, true, 3);
        SEAM(5);
        if (IN(6)) for (int rep_ = 0; rep_ < REP6; ++rep_) { pg8::Gemm g{p.A, p.wint, D, D, D}; pg8::StaticOrder S; S.init(MALL, 2048, G, cid); EpiQKVU E{p.qkv, p.Ur}; pg8::gemm_phase(lds, g, S, E); }
        SEAM(6);
        if (IN(7)) {
            { pg8::Gemm g{p.Ur, p.wE, UR_LD, 512, 512}; pg8::GroupOrder S{32, 5, 1, 5, 1, G, cid}; EpiF32 E{p.E, 256}; pg8::gemm_phase(lds, g, S, E); }
            for (int rep_ = 0; rep_ < REP7; ++rep_) na_phase(p, lds);
        }
        SEAM(7);
        if (IN(8)) for (int rep_ = 0; rep_ < REP8; ++rep_) s5_scan(p);
        SEAM(8);
        if (IN(9)) for (int rep_ = 0; rep_ < REP9; ++rep_) { pg8::Gemm g{p.Ur, p.wY, UR_LD, UR_LD, UR_LD}; pg8::GroupOrder S{32, 4, 2, 5, 2, G, cid}; EpiS5Y E{p.qkv}; pg8::gemm_phase(lds, g, S, E); }
        SEAM(9);
        if (IN(10)) for (int rep_ = 0; rep_ < REP10; ++rep_) { pg8::Gemm g{p.qkv, p.wglut, 512, 512, 512}; pg8::StaticOrder S; S.init(MLAT, 512, G, cid); EpiGlu E{p.qkv, p.b_glu, p.A}; pg8::gemm_phase(lds, g, S, E); }
        SEAM(10);
        if (IN(11)) { pg8::Gemm g{p.A, p.woutt, D, D, D}; pg8::StaticOrder S; S.init(MLAT, D, G, cid); EpiLnResGate E{p.V, p.stats, p.ln_g, p.ln_b, p.mod, 5, 1.0f}; pg8::gemm_phase(lds, g, S, E); }
        SEAM(11);
        if (IN(12)) for (int rep_ = 0; rep_ < REP12; ++rep_) ln_phase(p, 0, MLAT, cid, G, 1, nullptr, p.stats, true, 6);
        SEAM(12);
        if (IN(13)) for (int rep_ = 0; rep_ < REP13; ++rep_) { pg8::Gemm g{p.A, p.wup2t, D, D, D}; pg8::StaticOrder S; S.init(MLAT, 2 * DFF, G, cid); EpiSwiglu E{p.hid}; pg8::gemm_phase(lds, g, S, E); }
        SEAM(13);
        if (IN(14)) { pg8::Gemm g{p.hid, p.wdn2t, DFF, DFF, DFF}; pg8::StaticOrder S; S.init(MLAT, D, G, cid); EpiLnResGate E{p.V, p.stats, p.ln_g + 1024, p.ln_b + 1024, p.mod, 8, 0.5f}; pg8::gemm_phase(lds, g, S, E); }
        SEAM(14);
        if (IN(15)) for (int rep_ = 0; rep_ < REP15; ++rep_) ln_phase(p, 0, MLAT, cid, G, 2, p.out, nullptr, false, 0);
}

extern "C" void kernel_launch(void* const* d_in, const int* in_sizes, int n_in, void* d_out, int out_size, void* d_ws, size_t ws_size, hipStream_t stream) {
    static int grid_blocks = 0;
    if (!grid_blocks) {
        int dev = 0, cus = 0, per_cu = 0;
        hipGetDevice(&dev);
        hipDeviceGetAttribute(&cus, hipDeviceAttributeMultiprocessorCount, dev);
        hipFuncSetAttribute((const void*)mega, hipFuncAttributeMaxDynamicSharedMemorySize, LDS_BYTES);
        hipOccupancyMaxActiveBlocksPerMultiprocessor(&per_cu, (const void*)mega, 512, LDS_BYTES);
        if (per_cu < 1) { fprintf(stderr, "occupancy query reports %d blocks per CU\n", per_cu); per_cu = 1; }
        grid_blocks = cus * 1;
    }
    Params p{};
    const float* const* in = (const float* const*)d_in;
    p.x = in[0]; p.c = in[1]; p.ctx = in[2]; p.c_ctx = in[3]; p.w_ada = in[4]; p.b_ada = in[5]; p.ln_g = in[6]; p.ln_b = in[7];
    p.w_up1 = in[8]; p.w_dn1 = in[9]; p.w_in = in[10]; p.rpb = in[11]; p.a_re = in[12]; p.a_im = in[13]; p.log_dt = in[14];
    p.b_re = in[15]; p.b_im = in[16]; p.c_re = in[17]; p.c_im = in[18]; p.s5d = in[19]; p.w_glu = in[20]; p.b_glu = in[21];
    p.w_out = in[22]; p.w_up2 = in[23]; p.w_dn2 = in[24];
    p.out = (float*)d_out;
    unsigned char* ws = (unsigned char*)d_ws; size_t off = 0;
    auto take = [&](size_t bytes) { unsigned char* r = ws + off; off += (bytes + 255) & ~(size_t)255; return r; };
    p.bar = (unsigned*)take((size_t)XCD_BAR_WORDS * 4);
    p.mod = (float*)take((size_t)9 * 9216 * 4);
    p.stats = (float*)take((size_t)MALL * 2 * 4);
    p.wup1t = (bf16_t*)take((size_t)2 * DFF * D * 2); p.wdn1t = (bf16_t*)take((size_t)D * DFF * 2); p.wint = (bf16_t*)take((size_t)2048 * D * 2);
    p.wglut = (bf16_t*)take((size_t)512 * 512 * 2); p.woutt = (bf16_t*)take((size_t)D * D * 2);
    p.wup2t = (bf16_t*)take((size_t)2 * DFF * D * 2); p.wdn2t = (bf16_t*)take((size_t)D * DFF * 2);
    p.kt = (float*)take((size_t)2 * 32 * 32 * 256 * 4);
    p.wE = (bf16_t*)take((size_t)32 * 256 * 512 * 2);
    p.wY = (bf16_t*)take((size_t)32 * 512 * UR_LD * 2);
    p.A = (bf16_t*)take((size_t)MALL * D * 2);
    p.V = (float*)take((size_t)MALL * D * 4);
    p.hid = (bf16_t*)(ws + off);
    p.qkv = p.hid;
    p.Ur = (bf16_t*)((unsigned char*)p.qkv + (size_t)MALL * 1536 * 2);
    p.E = (float*)((unsigned char*)p.Ur + (size_t)32 * UR_ROWS * UR_LD * 2);
    const size_t endA = off + (size_t)MALL * DFF * 2, endB = (size_t)((unsigned char*)p.E - ws) + (size_t)32 * UR_ROWS * 256 * 4;
    if ((endA > endB ? endA : endB) > ws_size) { fprintf(stderr, "workspace too small: need %zu have %zu\n", endA > endB ? endA : endB, ws_size); return; }
#if N_LAUNCH_MODE == 1
    p.ph_lo = 0; p.ph_hi = NPHASE;
    if (hipMemsetAsync(p.bar, 0, (size_t)XCD_BAR_WORDS * 4, stream) != hipSuccess) { fprintf(stderr, "memset of barrier words failed\n"); return; }
    { void* args[] = {&p}; hipError_t e = hipLaunchCooperativeKernel((void*)mega, dim3(grid_blocks), dim3(512), args, LDS_BYTES, stream);
      if (e != hipSuccess) fprintf(stderr, "cooperative launch failed: %s (grid %d)\n", hipGetErrorString(e), grid_blocks); }
#else
    for (int ph = 0; ph < NPHASE; ++ph) {
        p.ph_lo = ph; p.ph_hi = ph + 1;
        void* args[] = {&p}; hipError_t e = hipLaunchCooperativeKernel((void*)mega, dim3(grid_blocks), dim3(512), args, LDS_BYTES, stream);
        if (e != hipSuccess) { fprintf(stderr, "cooperative launch failed: %s (grid %d, phase %d)\n", hipGetErrorString(e), grid_blocks, ph); break; }
    }
#endif
}
```
